# Optimizing an MI355X kernel written in HIP

```python
import jax
import jax.numpy as jnp
from jax import lax
import numpy as np

D_MODEL = 1024
BATCH = 4
SEQ = 4096
DEPTH = 4

N_HEADS = 8
HEAD_DIM = 64
N_KV = 2
HPG = N_HEADS // N_KV
ROT_DIM = HEAD_DIM // 4
ROPE_THETA = 500000.0
CMP_LEN = 32
CMP_STRIDE = 16
SLC_LEN = 64
SLC_TOPN = 16
WINDOW = 512
Q_BLOCK = 128
SLC_Q_CHUNK = 64
SCALE = HEAD_DIM ** -0.5
NEG = -1e30
FORCE_INIT = 1e6
FORCE_LOCAL = 2e6
POOL_GROUPS = 4
POOL_WINDOWS = (2, 4, 8, 16)
POOL_WIDTH = 512
POOL_GW = POOL_WIDTH // POOL_GROUPS
ATT_WIDTH = N_HEADS * HEAD_DIM
KV_WIDTH = 3 * 2 * N_KV * HEAD_DIM
GATE_NSA = 3 * N_HEADS
MERGE_GATES = 2 * D_MODEL
IN_WIDTH = ATT_WIDTH + KV_WIDTH + GATE_NSA + POOL_WIDTH + MERGE_GATES
SPLITS = (ATT_WIDTH, ATT_WIDTH + KV_WIDTH, ATT_WIDTH + KV_WIDTH + GATE_NSA,
          ATT_WIDTH + KV_WIDTH + GATE_NSA + POOL_WIDTH)
PEER_HEADS = 8
N_KEYS = 128
N_EXPERTS = N_KEYS * N_KEYS
PEER_TOPK = 16
PEER_DK = 128
PEER_CHUNK = 128
DN_ALPHA = (2 * DEPTH) ** 0.25
DN_BETA = (8 * DEPTH) ** -0.25
LN_EPS = 1e-5

kernel_name = 'nsa_pool_peer_hybrid'


def layer_norm(x, g, b):
    xf = x.astype(jnp.float32)
    mu = jnp.mean(xf, -1, keepdims=True)
    var = jnp.mean(jnp.square(xf - mu), -1, keepdims=True)
    return ((xf - mu) * lax.rsqrt(var + LN_EPS) * g + b).astype(x.dtype)


def rope_tables(pos):
    inv = ROPE_THETA ** (-jnp.arange(0, ROT_DIM, 2, dtype=jnp.float32) / ROT_DIM)
    ang = pos.astype(jnp.float32)[:, None] * inv[None, :]
    return jnp.cos(ang), jnp.sin(ang)


def apply_rope(z, cos, sin):
    half = ROT_DIM // 2
    z1, z2, zp = z[..., :half], z[..., half:ROT_DIM], z[..., ROT_DIM:]
    co = cos[:, None, :].astype(z.dtype)
    si = sin[:, None, :].astype(z.dtype)
    return jnp.concatenate([z1 * co - z2 * si, z1 * si + z2 * co, zp], axis=-1)


def compress(z, pe, w1, w2):
    B, S, G, dh = z.shape
    n_cmp = (S - CMP_LEN) // CMP_STRIDE + 1
    idx = jnp.arange(n_cmp)[:, None] * CMP_STRIDE + jnp.arange(CMP_LEN)[None, :]
    blocks = z[:, idx] + pe[:, None, :]
    flat = jnp.moveaxis(blocks, 3, 2).reshape(B, n_cmp, G, CMP_LEN * dh)
    return jax.nn.gelu(flat @ w1) @ w2


def cmp_to_slc(n_cmp, n_slc):
    st = jnp.arange(n_cmp) * CMP_STRIDE
    js = jnp.arange(n_slc) * SLC_LEN
    ov = (jnp.minimum(st[:, None] + CMP_LEN, js[None, :] + SLC_LEN)
          - jnp.maximum(st[:, None], js[None, :]))
    return jnp.maximum(ov, 0).astype(jnp.float32) / CMP_STRIDE


def sel_attend(qg, idx, k, v, t):
    B, S, G, _, dh = qg.shape
    n_slc = S // SLC_LEN
    n_sel = idx.shape[-1]
    kt = k.reshape(B, n_slc, SLC_LEN, G, dh).transpose(0, 3, 1, 2, 4)
    vt = v.reshape(B, n_slc, SLC_LEN, G, dh).transpose(0, 3, 1, 2, 4)
    n_chunk = S // SLC_Q_CHUNK
    bi = jnp.arange(B)[:, None, None, None]
    gi = jnp.arange(G)[None, None, :, None]

    def chunk(args):
        qc, ic, tc = args
        kb = kt[bi, gi, ic]
        vb = vt[bi, gi, ic]
        s = jnp.einsum('bcghd,bcgnld->bcghnl', qc, kb).astype(jnp.float32) * SCALE
        kpos = ic[..., None] * SLC_LEN + jnp.arange(SLC_LEN)
        ok = kpos <= tc[None, :, None, None, None]
        s = jnp.where(ok[:, :, :, None], s, NEG)
        p = jax.nn.softmax(s.reshape(s.shape[:4] + (-1,)), axis=-1).reshape(s.shape)
        return jnp.einsum('bcghnl,bcgnld->bcghd', p.astype(vb.dtype), vb)

    qs = qg.reshape(B, n_chunk, SLC_Q_CHUNK, G, HPG, dh).swapaxes(0, 1)
    isel = idx.reshape(B, n_chunk, SLC_Q_CHUNK, G, n_sel).swapaxes(0, 1)
    ts = t.reshape(n_chunk, SLC_Q_CHUNK)
    o = lax.map(chunk, (qs, isel, ts))
    return o.swapaxes(0, 1).reshape(B, S, G, HPG, dh)


def win_attend(qg, k, v, t):
    B, S, G, _, dh = qg.shape
    nb = S // Q_BLOCK
    nw = WINDOW // Q_BLOCK

    def bands(z):
        zp = jnp.pad(z, ((0, 0), (WINDOW, 0), (0, 0), (0, 0))).reshape(B, nb + nw, Q_BLOCK, G, dh)
        return jnp.concatenate([zp[:, i:i + nb] for i in range(nw + 1)], axis=2)

    kb, vb = bands(k), bands(v)
    qb = qg.reshape(B, nb, Q_BLOCK, G, HPG, dh)
    s = jnp.einsum('bnqghd,bnkgd->bnghqk', qb, kb).astype(jnp.float32) * SCALE
    tq = t.reshape(nb, Q_BLOCK)
    kpos = (jnp.arange(nb) * Q_BLOCK - WINDOW)[:, None] + jnp.arange((nw + 1) * Q_BLOCK)[None, :]
    diff = tq[:, :, None] - kpos[:, None, :]
    ok = (diff >= 0) & (diff < WINDOW) & (kpos[:, None, :] >= 0)
    s = jnp.where(ok[None, :, None, None], s, NEG)
    p = jax.nn.softmax(s, axis=-1)
    o = jnp.einsum('bnghqk,bnkgd->bnqghd', p.astype(vb.dtype), vb)
    return o.reshape(B, S, G, HPG, dh)


def multiscale_pool(p, w_pool, pool_scale):
    B, S, _ = p.shape
    pf = p.reshape(B, S, POOL_GROUPS, POOL_GW).astype(jnp.float32)
    cs = jnp.pad(jnp.cumsum(pf, axis=1), ((0, 0), (1, 0), (0, 0), (0, 0)))
    t = jnp.arange(S)
    win = jnp.array(POOL_WINDOWS)
    lo_idx = jnp.maximum(t[:, None] + 1 - win[None, :], 0)
    lo = cs[:, lo_idx, jnp.arange(POOL_GROUPS)[None, :]]
    cnt = jnp.minimum(t[:, None] + 1, win[None, :]).astype(jnp.float32)
    pooled = (cs[:, 1:] - lo) / cnt[None, :, :, None] - pf
    y = jnp.einsum('bsgc,gcd->bsgd', pooled.astype(p.dtype), w_pool).reshape(B, S, POOL_WIDTH)
    return y * pool_scale


def token_mixer(h, w_in, cmp_pe, cmp_w1, cmp_w2, w_pool, pool_scale, w_lift, w_o, cos, sin, cos_c, sin_c):
    B, S, _ = h.shape
    t = jnp.arange(S)
    q, kv, g_nsa, p_in, g_mrg = jnp.split(h @ w_in, SPLITS, axis=-1)
    q = apply_rope(q.reshape(B, S, N_HEADS, HEAD_DIM), cos, sin).reshape(B, S, N_KV, HPG, HEAD_DIM)
    kv = kv.reshape(B, S, 3, 2, N_KV, HEAD_DIM)

    k_c = apply_rope(compress(kv[:, :, 0, 0], cmp_pe[0], cmp_w1[0], cmp_w2[0]), cos_c, sin_c)
    v_c = compress(kv[:, :, 0, 1], cmp_pe[1], cmp_w1[1], cmp_w2[1])
    n_cmp = k_c.shape[1]
    cmp_end = jnp.arange(n_cmp) * CMP_STRIDE + CMP_LEN - 1
    vis = cmp_end[None, :] <= t[:, None]
    s = jnp.einsum('bsghd,bcgd->bsghc', q, k_c).astype(jnp.float32) * SCALE
    s = jnp.where(vis[None, :, None, None], s, NEG)
    any_vis = jnp.any(vis, axis=-1).astype(jnp.float32)[None, :, None, None, None]
    p_cmp = jax.nn.softmax(s, axis=-1) * any_vis
    o_cmp = jnp.einsum('bsghc,bcgd->bsghd', p_cmp.astype(v_c.dtype), v_c)

    n_slc = S // SLC_LEN
    imp = jnp.einsum('bsghc,cj->bsgj', p_cmp, cmp_to_slc(n_cmp, n_slc))
    blk = jnp.arange(n_slc)
    cur = (t // SLC_LEN)[:, None]
    score = jnp.where((blk[None, :] <= cur)[None, :, None, :], imp, NEG)
    score = jnp.where((blk == 0)[None, None, None, :], FORCE_INIT, score)
    score = jnp.where((blk[None, :] == cur)[None, :, None, :], FORCE_LOCAL, score)
    _, sel_idx = lax.top_k(score, min(SLC_TOPN, n_slc))
    o_slc = sel_attend(q, sel_idx, apply_rope(kv[:, :, 1, 0], cos, sin), kv[:, :, 1, 1], t)

    o_win = win_attend(q, apply_rope(kv[:, :, 2, 0], cos, sin), kv[:, :, 2, 1], t)

    gate = jax.nn.sigmoid(g_nsa.reshape(B, S, N_KV, HPG, 3))
    o_att = (gate[..., 0:1] * o_cmp + gate[..., 1:2] * o_slc
             + gate[..., 2:3] * o_win).reshape(B, S, ATT_WIDTH)

    o_pool = multiscale_pool(p_in, w_pool, pool_scale)

    g_a, g_b = jnp.split(jax.nn.sigmoid(g_mrg), 2, axis=-1)
    merged = g_a * (o_att @ w_lift[0]) + g_b * (o_pool @ w_lift[1])
    return merged @ w_o


def peer_ffn(h, w_pq, sub_keys, u_tab, v_tab):
    B, S, D = h.shape
    q = (h @ w_pq).reshape(B, S, PEER_HEADS, 2, PEER_DK // 2)
    s = jnp.einsum('bshpd,hpkd->bshpk', q, sub_keys).astype(jnp.float32)
    s1, i1 = lax.top_k(s[..., 0, :], PEER_TOPK)
    s2, i2 = lax.top_k(s[..., 1, :], PEER_TOPK)
    cand = (s1[..., :, None] + s2[..., None, :]).reshape(B, S, PEER_HEADS, -1)
    cand_idx = (i1[..., :, None] * N_KEYS + i2[..., None, :]).reshape(B, S, PEER_HEADS, -1)
    sv, si = lax.top_k(cand, PEER_TOPK)
    eidx = jnp.take_along_axis(cand_idx, si, axis=-1)
    g = jax.nn.softmax(sv, axis=-1)
    n_chunk = (B * S) // PEER_CHUNK
    hf = h.reshape(n_chunk, PEER_CHUNK, D)
    ef = eidx.reshape(n_chunk, PEER_CHUNK, PEER_HEADS * PEER_TOPK)
    gf = g.reshape(n_chunk, PEER_CHUNK, PEER_HEADS * PEER_TOPK).astype(h.dtype)

    def body(args):
        hc, ec, gc = args
        a = jax.nn.gelu(jnp.einsum('cd,ced->ce', hc, u_tab[ec]))
        return jnp.einsum('ce,ced->cd', gc * a, v_tab[ec])

    return lax.map(body, (hf, ef, gf)).reshape(B, S, D)


def setup_inputs(seed: int = 0) -> dict:
    key = jax.random.key(seed)
    ks = jax.random.split(key, 20)
    f32 = jnp.float32
    nrm = lambda k, shp, sc: jax.random.normal(k, shp, f32) * sc
    return {
        'x': nrm(ks[0], (BATCH, SEQ, D_MODEL), 1.0),
        'c': nrm(ks[1], (BATCH, D_MODEL), 1.0),
        'w_ada': nrm(ks[2], (DEPTH, D_MODEL, 6 * D_MODEL), D_MODEL ** -0.5),
        'b_ada': nrm(ks[3], (DEPTH, 6 * D_MODEL), 0.02),
        'w_in': nrm(ks[4], (DEPTH, D_MODEL, IN_WIDTH), D_MODEL ** -0.5),
        'cmp_pe': nrm(ks[5], (DEPTH, 2, CMP_LEN, HEAD_DIM), 0.02),
        'cmp_w1': nrm(ks[6], (DEPTH, 2, CMP_LEN * HEAD_DIM, HEAD_DIM), (CMP_LEN * HEAD_DIM) ** -0.5),
        'cmp_w2': nrm(ks[7], (DEPTH, 2, HEAD_DIM, HEAD_DIM), HEAD_DIM ** -0.5),
        'w_pool': nrm(ks[8], (DEPTH, POOL_GROUPS, POOL_GW, POOL_GW), POOL_GW ** -0.5),
        'pool_scale': 1.0 + nrm(ks[9], (DEPTH, POOL_WIDTH), 0.02),
        'w_lift': nrm(ks[10], (DEPTH, 2, ATT_WIDTH, D_MODEL), ATT_WIDTH ** -0.5),
        'w_o': nrm(ks[11], (DEPTH, D_MODEL, D_MODEL), D_MODEL ** -0.5 * DN_BETA),
        'ln_g': 1.0 + nrm(ks[12], (DEPTH, 2, D_MODEL), 0.02),
        'ln_b': nrm(ks[13], (DEPTH, 2, D_MODEL), 0.02),
        'peer_wq': nrm(ks[14], (DEPTH, D_MODEL, PEER_HEADS * PEER_DK), D_MODEL ** -0.5),
        'peer_keys': nrm(ks[15], (DEPTH, PEER_HEADS, 2, N_KEYS, PEER_DK // 2), (PEER_DK // 2) ** -0.5),
        'peer_u': nrm(ks[16], (DEPTH, N_EXPERTS, D_MODEL), D_MODEL ** -0.5),
        'peer_v': nrm(ks[17], (DEPTH, N_EXPERTS, D_MODEL), (PEER_HEADS * PEER_TOPK) ** -0.5 * DN_BETA),
    }


def reference(x, c, w_ada, b_ada, w_in, cmp_pe, cmp_w1, cmp_w2, w_pool, pool_scale, w_lift, w_o,
              ln_g, ln_b, peer_wq, peer_keys, peer_u, peer_v):
    S = x.shape[1]
    cos, sin = rope_tables(jnp.arange(S))
    n_cmp = (S - CMP_LEN) // CMP_STRIDE + 1
    cos_c, sin_c = rope_tables(jnp.arange(n_cmp) * CMP_STRIDE + CMP_LEN - 1)
    c_act = jax.nn.silu(c)
    for l in range(DEPTH):
        mods = c_act @ w_ada[l] + b_ada[l]
        sh1, sc1, g1, sh2, sc2, g2 = [m[:, None, :] for m in jnp.split(mods, 6, axis=-1)]
        h = x * (1.0 + sc1) + sh1
        y = token_mixer(h, w_in[l], cmp_pe[l], cmp_w1[l], cmp_w2[l], w_pool[l], pool_scale[l],
                        w_lift[l], w_o[l], cos, sin, cos_c, sin_c)
        x = layer_norm(DN_ALPHA * x + g1 * y, ln_g[l, 0], ln_b[l, 0])
        h = x * (1.0 + sc2) + sh2
        y = peer_ffn(h, peer_wq[l], peer_keys[l], peer_u[l], peer_v[l])
        x = layer_norm(DN_ALPHA * x + g2 * y, ln_g[l, 1], ln_b[l, 1])
    return x
```

```cpp
#include <hip/hip_runtime.h>
#include <hip/hip_cooperative_groups.h>
#include <stdint.h>
#include <cstdio>
namespace cg = cooperative_groups;

typedef unsigned short u16;
typedef __attribute__((ext_vector_type(8))) short bf16x8;
typedef __attribute__((ext_vector_type(4))) short s16x4;
typedef __attribute__((ext_vector_type(16))) float f32x16;
typedef __attribute__((ext_vector_type(4))) float f32x4;
typedef __attribute__((ext_vector_type(2))) float f32x2;
typedef __attribute__((ext_vector_type(4))) unsigned u32x4;
typedef __attribute__((ext_vector_type(2))) unsigned u32x2;
typedef __attribute__((ext_vector_type(2))) __bf16 bf16x2v;

#define DI __device__ __forceinline__
#define MFMA32(a, b, c) __builtin_amdgcn_mfma_f32_32x32x16_bf16((a), (b), (c), 0, 0, 0)
#define MFMA16(a, b, c) __builtin_amdgcn_mfma_f32_16x16x32_bf16((a), (b), (c), 0, 0, 0)

#ifndef DO_MIXER
#define DO_MIXER 1
#endif
#ifndef PHM
#define PHM 255
#endif
#ifndef REP_G1
#define REP_G1 1
#endif
#ifndef REP_ATT
#define REP_ATT 1
#endif
#ifndef REP_ROUTE
#define REP_ROUTE 1
#endif
#ifndef REP_GATHER
#define REP_GATHER 1
#endif
#ifndef REP_CP
#define REP_CP 1
#endif
#ifndef DO_PEER
#define DO_PEER 1
#endif

constexpr int T = 16384, S = 4096, NL = 4;
constexpr int NPAD = 4096;
constexpr float L2E = 1.4426950408889634f;
constexpr float DN_ALPHA = 1.681792830507429f;

constexpr size_t OFF_X = 0;
constexpr size_t OFF_R = OFF_X + (size_t)T * 1024 * 4;
constexpr size_t OFF_H = OFF_R + (size_t)T * 1024 * 4;
constexpr size_t OFF_Q = OFF_H + (size_t)T * 1024 * 2;
constexpr size_t OFF_KV0 = OFF_Q + (size_t)T * 512 * 2;
constexpr size_t OFF_K12 = OFF_KV0 + (size_t)T * 256 * 2;
constexpr size_t OFF_VT = OFF_K12 + (size_t)T * 256 * 2;
constexpr size_t OFF_GATE = OFF_VT + (size_t)T * 256 * 2;
constexpr size_t OFF_PIN = OFF_GATE + (size_t)T * 24 * 4;
constexpr size_t OFF_GM = OFF_PIN + (size_t)T * 512 * 2;
constexpr size_t OFF_KC = OFF_GM + (size_t)T * 2048 * 2;
constexpr size_t OFF_VCT = OFF_KC + (size_t)4 * 2 * 256 * 64 * 2;
constexpr size_t OFF_OPOOL = OFF_VCT + (size_t)4 * 2 * 256 * 64 * 2;
constexpr size_t OFF_OATT = OFF_OPOOL + (size_t)T * 512 * 2;
constexpr size_t OFF_OACC = OFF_OATT + (size_t)T * 512 * 2;
constexpr size_t OFF_MERGED = OFF_OACC + (size_t)T * 512 * 4;
constexpr size_t OFF_PQ = OFF_MERGED + (size_t)T * 1024 * 2;
constexpr size_t OFF_EIDX = OFF_PQ + (size_t)T * 1024 * 2;
constexpr size_t OFF_EG = OFF_EIDX + (size_t)T * 128 * 4;
constexpr size_t OFF_MODS = OFF_EG + (size_t)T * 128 * 4;
constexpr size_t OFF_ROPE = OFF_MODS + (size_t)NL * 4 * 6144 * 4;
constexpr size_t OFF_CBIAS = OFF_ROPE + (size_t)4096 * 16 * 4;
constexpr size_t OFF_WIN = OFF_CBIAS + 16384;
constexpr size_t OFF_LIFT = OFF_WIN + (size_t)NL * NPAD * 1024 * 2;
constexpr size_t OFF_WO = OFF_LIFT + (size_t)NL * 2 * 1024 * 512 * 2;
constexpr size_t OFF_WQ = OFF_WO + (size_t)NL * 1024 * 1024 * 2;
constexpr size_t OFF_W1T = OFF_WQ + (size_t)NL * 1024 * 1024 * 2;
constexpr size_t OFF_W2T = OFF_W1T + (size_t)NL * 2 * 64 * 2048 * 2;
constexpr size_t OFF_WPT = OFF_W2T + (size_t)NL * 2 * 64 * 64 * 2;
constexpr size_t OFF_KEYS = OFF_WPT + (size_t)NL * 4 * 128 * 128 * 2;
constexpr size_t OFF_U = OFF_KEYS + (size_t)NL * 8 * 2 * 128 * 64 * 2;
constexpr size_t OFF_V = OFF_U + (size_t)NL * 16384 * 1024;
constexpr size_t OFF_USC = OFF_V + (size_t)NL * 16384 * 1024;
constexpr size_t OFF_VSC = OFF_USC + (size_t)NL * 16384 * 4;
constexpr size_t OFF_STATS = OFF_VSC + (size_t)NL * 16384 * 4;
constexpr size_t OFF_BAR = OFF_STATS + (size_t)T * 2 * 4;
constexpr int MT_CNT_WORD = 3600;
constexpr size_t WS_END = OFF_BAR + 16384;

struct Params {
  const float *x, *c, *w_ada, *b_ada, *w_in, *cmp_pe, *cmp_w1, *cmp_w2, *w_pool, *pool_scale, *w_lift, *w_o, *ln_g,
      *ln_b, *peer_wq, *peer_keys, *peer_u, *peer_v;
  float* out;
  char* ws;
};

DI int otid() { int t = threadIdx.x; asm volatile("" : "+v"(t)); return t; }
DI int crow(int e, int h) { return (e & 3) + 8 * (e >> 2) + 4 * h; }
DI unsigned pk2(float a, float b) {
  f32x2 f = {a, b};
  bf16x2v r = __builtin_convertvector(f, bf16x2v);
  return __builtin_bit_cast(unsigned, r);
}
DI u16 f2bf(float a) { return (u16)(pk2(a, 0.f) & 0xffffu); }
DI float bflo(unsigned u) { return __uint_as_float(u << 16); }
DI float bfhi(unsigned u) { return __uint_as_float(u & 0xffff0000u); }
DI float bf2f(u16 v) { return __uint_as_float(((unsigned)v) << 16); }
DI float ex2(float x) { return __builtin_amdgcn_exp2f(x); }
DI float sigmoidf_(float x) { return 1.f / (1.f + __expf(-x)); }
DI float gelu_tanh(float x) {
  float u = 0.7978845608028654f * (x + 0.044715f * x * x * x);
  float e = __expf(2.f * u);
  float th = 1.f - 2.f / (e + 1.f);
  return 0.5f * x * (1.f + th);
}
DI f32x16 zero16() {
  f32x16 z;
#pragma unroll
  for (int i = 0; i < 16; ++i) z[i] = 0.f;
  return z;
}
DI float wsum(float v) {
#pragma unroll
  for (int o = 32; o > 0; o >>= 1) v += __shfl_xor(v, o);
  return v;
}
DI float xh_max(float x) {
  const u32x2 r_ = __builtin_amdgcn_permlane32_swap(__float_as_uint(x), __float_as_uint(x), false, false);
  return fmaxf(__uint_as_float(r_[0]), __uint_as_float(r_[1]));
}
DI unsigned umax_(unsigned a, unsigned b) { return a > b ? a : b; }
DI unsigned shx(unsigned v, int m) { return (unsigned)__shfl_xor((int)v, m); }

constexpr int G_LS = 40;
constexpr int G_STG = (128 + 256) * G_LS;
DI void gemm_main(const u16* A, int lda, const u16* B, int ldb, int K, int m0, int n0, f32x16 (&acc)[2][4], u16* sm) {
  const int tid = otid(), lane = tid & 63, w = tid >> 6, wm = w >> 1, wn = w & 1, r = lane & 31, h = lane >> 5;
  const int lrow = tid >> 2, lk = (tid & 3) * 8;
  const unsigned voa = (unsigned)(lrow * lda + lk) * 2u;
  const unsigned vob = (unsigned)((4 * (lrow & 31) + (lrow >> 5)) * ldb + lk) * 2u;
  const char* Ab0 = (const char*)(A + (size_t)m0 * lda);
  const char* Bb0 = (const char*)(B + (size_t)n0 * ldb);
  const size_t sa = (size_t)64 * lda * 2, sb = (size_t)64 * ldb * 2;
  u32x4 ra0[2], rb0[4], ra1[2], rb1[4];
#define GLOAD(RA, RB, K0)                                                                               \
  {                                                                                                     \
    _Pragma("unroll") for (int i = 0; i < 2; ++i) RA[i] = *(const u32x4*)(Ab0 + i * sa + (size_t)(K0) * 2 + voa); \
    _Pragma("unroll") for (int i = 0; i < 4; ++i) RB[i] = *(const u32x4*)(Bb0 + (size_t)((i >> 1) * 128 + (i & 1) * 2) * ldb * 2 + (size_t)(K0) * 2 + vob); \
  }
#define SSTORE(RA, RB, ST)                                                                                      \
  {                                                                                                             \
    _Pragma("unroll") for (int i = 0; i < 2; ++i) *(u32x4*)(sm + (ST) * G_STG + (lrow + 64 * i) * G_LS + lk) = RA[i]; \
    _Pragma("unroll") for (int i = 0; i < 4; ++i) *(u32x4*)(sm + (ST) * G_STG + (128 + lrow + 64 * i) * G_LS + lk) = RB[i]; \
  }
#define COMPUTE(ST)                                                                                   \
  {                                                                                                   \
    const u16* Ab = sm + (ST) * G_STG + (wm * 64 + r) * G_LS + 8 * h;                                 \
    const u16* Bb = sm + (ST) * G_STG + (128 + wn * 128 + r) * G_LS + 8 * h;                          \
    bf16x8 af[2][2];                                                                                  \
    _Pragma("unroll") for (int ks = 0; ks < 2; ++ks) {                                                \
      af[ks][0] = *(const bf16x8*)(Ab + 16 * ks);                                                     \
      af[ks][1] = *(const bf16x8*)(Ab + 32 * G_LS + 16 * ks);                                         \
    }                                                                                                 \
    bf16x8 b0 = *(const bf16x8*)(Bb), b1 = *(const bf16x8*)(Bb + 16);                                 \
    _Pragma("unroll") for (int j = 0; j < 4; ++j) {                                                   \
      bf16x8 nb0 = b0, nb1 = b1;                                                                      \
      if (j < 3) { nb0 = *(const bf16x8*)(Bb + 32 * (j + 1) * G_LS); nb1 = *(const bf16x8*)(Bb + 32 * (j + 1) * G_LS + 16); } \
      acc[0][j] = MFMA32(af[0][0], b0, acc[0][j]);                                                    \
      acc[1][j] = MFMA32(af[0][1], b0, acc[1][j]);                                                    \
      acc[0][j] = MFMA32(af[1][0], b1, acc[0][j]);                                                    \
      acc[1][j] = MFMA32(af[1][1], b1, acc[1][j]);                                                    \
      b0 = nb0; b1 = nb1;                                                                             \
      __builtin_amdgcn_sched_barrier(0);                                                              \
    }                                                                                                 \
  }
  GLOAD(ra0, rb0, 0)
  GLOAD(ra1, rb1, 32)
  __syncthreads();
  SSTORE(ra0, rb0, 0)
  __syncthreads();
  const int nk = K >> 5;
  for (int kt = 0; kt < nk; kt += 2) {
    { const int k2 = (kt + 2 < nk) ? (kt + 2) * 32 : (K - 64); GLOAD(ra0, rb0, k2) }
    __builtin_amdgcn_sched_barrier(0);
    COMPUTE(0)
    SSTORE(ra1, rb1, 1)
    __syncthreads();
    { const int k3 = (kt + 3 < nk) ? (kt + 3) * 32 : (K - 32); GLOAD(ra1, rb1, k3) }
    __builtin_amdgcn_sched_barrier(0);
    COMPUTE(1)
    SSTORE(ra0, rb0, 0)
    __syncthreads();
  }
#undef GLOAD
#undef SSTORE
#undef COMPUTE
}

DI void gemm_tile(int q, int NT, int& mt, int& nt) {
  const int x = blockIdx.x & 7;
  const int PN = NT < 8 ? NT : 8, PM = 64 / PN, NG = NT / PN;
  const int p = q >> 6, mi = q % PM, ni = (q / PM) % PN;
  const int ng = p % NG, mh = p / NG;
  mt = 16 * x + PM * mh + mi;
  nt = PN * ng + ni;
}
#define GEMM_TILE_LOOP(NT) for (int q = blockIdx.x >> 3; q < 16 * (NT); q += gridDim.x >> 3)
#define ACC_ZERO(acc)                                   \
  _Pragma("unroll") for (int i = 0; i < 2; ++i)         \
  _Pragma("unroll") for (int j = 0; j < 4; ++j) acc[i][j] = zero16();

DI int win_colmap(int n) {
  if (n < 1280) return n;
  if (n < 1792) return 1304 + (n - 1280);
  if (n < 3840) return 1816 + (n - 1792);
  if (n < 3864) return 1280 + (n - 3840);
  return -1;
}

DI void tr_family(const float* src, size_t src_mat, int ldsrc, u16* dst, size_t dst_mat, int K, int Ndst, int nmat,
                  int mode, float* sm) {
  const int tid = otid();
  const int tk = K >> 6, tn = Ndst >> 6;
  const int per = tk * tn;
  for (int it = blockIdx.x; it < per * nmat; it += gridDim.x) {
    const int mat = it / per, rem = it % per;
    const int k0 = (rem / tn) * 64, n0 = (rem % tn) * 64;
    const float* s = src + (size_t)mat * src_mat;
    u16* d = dst + (size_t)mat * dst_mat;
    const int tx = tid & 63, ty = tid >> 6;
    const int nd = n0 + tx;
    const int ns = (mode == 1) ? win_colmap(nd) : nd;
    __syncthreads();
    float tv[16];
#pragma unroll
    for (int i = 0; i < 16; ++i) tv[i] = (ns >= 0) ? s[(size_t)(k0 + ty + 4 * i) * ldsrc + ns] : 0.f;
#pragma unroll
    for (int i = 0; i < 16; ++i) sm[(ty + 4 * i) * 65 + tx] = tv[i];
    __syncthreads();
    const int nr = tid >> 2, kseg = (tid & 3) * 16;
    unsigned pkd[8];
#pragma unroll
    for (int j = 0; j < 8; ++j) pkd[j] = pk2(sm[(kseg + 2 * j) * 65 + nr], sm[(kseg + 2 * j + 1) * 65 + nr]);
    uint4* dp = (uint4*)(d + (size_t)(n0 + nr) * K + k0 + kseg);
    dp[0] = make_uint4(pkd[0], pkd[1], pkd[2], pkd[3]);
    dp[1] = make_uint4(pkd[4], pkd[5], pkd[6], pkd[7]);
  }
}

DI void conv_plain(const float* src, u16* dst, size_t n) {
  const size_t gt = (size_t)blockIdx.x * 256 + otid(), gs = (size_t)gridDim.x * 256;
  for (size_t i = gt; i < n / 8; i += gs) {
    const float4 a = ((const float4*)src)[2 * i], b = ((const float4*)src)[2 * i + 1];
    ((uint4*)dst)[i] = make_uint4(pk2(a.x, a.y), pk2(a.z, a.w), pk2(b.x, b.y), pk2(b.z, b.w));
  }
}

DI void conv_fp8_rows(const float* src, unsigned char* dst, float* inv_scale, int nrows) {
  const int tid = otid(), lane = tid & 63, w = tid >> 6;
  for (int row0 = (blockIdx.x * 4 + w) * 4; row0 < nrows; row0 += gridDim.x * 16) {
    f32x4 v[4][4];
#pragma unroll
    for (int rr = 0; rr < 4; ++rr) {
      const f32x4* sp = (const f32x4*)(src + (size_t)(row0 + rr) * 1024 + lane * 16);
#pragma unroll
      for (int q = 0; q < 4; ++q) v[rr][q] = __builtin_nontemporal_load(sp + q);
    }
#pragma unroll
    for (int rr = 0; rr < 4; ++rr) {
      float am = 0.f;
#pragma unroll
      for (int q = 0; q < 4; ++q)
        am = fmaxf(am, fmaxf(fmaxf(fabsf(v[rr][q].x), fabsf(v[rr][q].y)), fmaxf(fabsf(v[rr][q].z), fabsf(v[rr][q].w))));
#pragma unroll
      for (int o = 32; o > 0; o >>= 1) am = fmaxf(am, __shfl_xor(am, o));
      const float sc = (am > 0.f) ? (6.f / am) : 1.f;
      u32x2 out;
#pragma unroll
      for (int d = 0; d < 2; ++d) {
        unsigned wd = 0u;
        wd = __builtin_amdgcn_cvt_scalef32_pk_fp4_f32(wd, v[rr][2 * d].x * sc, v[rr][2 * d].y * sc, 1.0f, 0);
        wd = __builtin_amdgcn_cvt_scalef32_pk_fp4_f32(wd, v[rr][2 * d].z * sc, v[rr][2 * d].w * sc, 1.0f, 1);
        wd = __builtin_amdgcn_cvt_scalef32_pk_fp4_f32(wd, v[rr][2 * d + 1].x * sc, v[rr][2 * d + 1].y * sc, 1.0f, 2);
        wd = __builtin_amdgcn_cvt_scalef32_pk_fp4_f32(wd, v[rr][2 * d + 1].z * sc, v[rr][2 * d + 1].w * sc, 1.0f, 3);
        out[d] = wd;
      }
      *(u32x2*)(dst + (size_t)(row0 + rr) * 512 + lane * 8) = out;
      if (lane == 0) inv_scale[row0 + rr] = (am > 0.f) ? (am / 6.f) : 1.f;
    }
  }
}

DI void convert_layer_weights(const Params& P, int l, float* smf) {
  tr_family(P.w_in + (size_t)l * 1024 * 3864, 0, 3864, (u16*)(P.ws + OFF_WIN) + (size_t)l * NPAD * 1024, 0, 1024, NPAD, 1, 1, smf);
  tr_family(P.w_lift + (size_t)l * 2 * 512 * 1024, (size_t)512 * 1024, 1024, (u16*)(P.ws + OFF_LIFT) + (size_t)l * 2 * 1024 * 512,
            (size_t)1024 * 512, 512, 1024, 2, 0, smf);
  tr_family(P.w_o + (size_t)l * 1024 * 1024, 0, 1024, (u16*)(P.ws + OFF_WO) + (size_t)l * 1024 * 1024, 0, 1024, 1024, 1, 0, smf);
  tr_family(P.peer_wq + (size_t)l * 1024 * 1024, 0, 1024, (u16*)(P.ws + OFF_WQ) + (size_t)l * 1024 * 1024, 0, 1024, 1024, 1, 0, smf);
  tr_family(P.cmp_w1 + (size_t)l * 2 * 2048 * 64, (size_t)2048 * 64, 64, (u16*)(P.ws + OFF_W1T) + (size_t)l * 2 * 64 * 2048,
            (size_t)64 * 2048, 2048, 64, 2, 0, smf);
  tr_family(P.cmp_w2 + (size_t)l * 2 * 64 * 64, (size_t)64 * 64, 64, (u16*)(P.ws + OFF_W2T) + (size_t)l * 2 * 64 * 64,
            (size_t)64 * 64, 64, 64, 2, 0, smf);
  tr_family(P.w_pool + (size_t)l * 4 * 128 * 128, (size_t)128 * 128, 128, (u16*)(P.ws + OFF_WPT) + (size_t)l * 4 * 128 * 128,
            (size_t)128 * 128, 128, 128, 4, 0, smf);
  conv_plain(P.peer_keys + (size_t)l * 8 * 2 * 128 * 64, (u16*)(P.ws + OFF_KEYS) + (size_t)l * 8 * 2 * 128 * 64,
             (size_t)8 * 2 * 128 * 64);
  __syncthreads();
}
DI void convert_layer_peer(const Params& P, int l) {
#if DO_PEER
  conv_fp8_rows(P.peer_u + (size_t)l * 16384 * 1024, (unsigned char*)(P.ws + OFF_U) + (size_t)l * 16384 * 512,
                (float*)(P.ws + OFF_USC) + (size_t)l * 16384, 16384);
  conv_fp8_rows(P.peer_v + (size_t)l * 16384 * 1024, (unsigned char*)(P.ws + OFF_V) + (size_t)l * 16384 * 512,
                (float*)(P.ws + OFF_VSC) + (size_t)l * 16384, 16384);
#endif
}

DI void phase0a(const Params& P, char* smraw) {
  const int tid = otid(), nb = gridDim.x, bid = blockIdx.x;
  float* smf = (float*)smraw;
  float* MODS = (float*)(P.ws + OFF_MODS);
  {
    float* cact = smf;
    float* red = smf + 4096;
    for (int it = bid; it < 384; it += nb) {
      const int l = it / 96, ch = it % 96;
      __syncthreads();
      for (int i = tid; i < 4096; i += 256) {
        const float v = P.c[i];
        cact[i] = v / (1.f + __expf(-v));
      }
      __syncthreads();
      const int kq = tid >> 6, n = tid & 63, col = ch * 64 + n;
      float a0 = 0, a1 = 0, a2 = 0, a3 = 0;
      const float* wp = P.w_ada + ((size_t)l * 1024 + kq * 256) * 6144 + col;
#pragma unroll 32
      for (int k = 0; k < 256; ++k) {
        const float wv = __builtin_nontemporal_load(wp + (size_t)k * 6144);
        const int kk = kq * 256 + k;
        a0 += cact[kk] * wv;
        a1 += cact[1024 + kk] * wv;
        a2 += cact[2048 + kk] * wv;
        a3 += cact[3072 + kk] * wv;
      }
      red[(kq * 4 + 0) * 64 + n] = a0;
      red[(kq * 4 + 1) * 64 + n] = a1;
      red[(kq * 4 + 2) * 64 + n] = a2;
      red[(kq * 4 + 3) * 64 + n] = a3;
      __syncthreads();
      {
        const int b = tid >> 6;
        const float s = red[(0 * 4 + b) * 64 + n] + red[(1 * 4 + b) * 64 + n] + red[(2 * 4 + b) * 64 + n] +
                        red[(3 * 4 + b) * 64 + n] + P.b_ada[l * 6144 + col];
        MODS[(size_t)(l * 4 + b) * 6144 + col] = s;
      }
    }
  }
  {
    float* ROPE = (float*)(P.ws + OFF_ROPE);
    for (int i = bid * 256 + tid; i < 4096 * 8; i += nb * 256) {
      const int pos = i >> 3, fi = i & 7;
      const float inv = exp2f(-(float)fi * 0.125f * 18.931568569324174f);
      const float ang = (float)pos * inv;
      const double xr = (double)ang * 0.15915494309189535;
      const float fr = (float)(xr - floor(xr));
      ROPE[pos * 16 + fi] = __builtin_amdgcn_cosf(fr);
      ROPE[pos * 16 + 8 + fi] = __builtin_amdgcn_sinf(fr);
    }
  }
  {
    float* CB = (float*)(P.ws + OFF_CBIAS);
    float* red = smf;
    for (int it2 = bid; it2 < 64; it2 += nb) {
      const int it = it2 >> 3, kc = it2 & 7;
      __syncthreads();
      const int kq = tid >> 6, n = tid & 63;
      const float* pe = P.cmp_pe + (size_t)it * 2048 + kc * 256 + kq * 64;
      const float* w1 = P.cmp_w1 + ((size_t)it * 2048 + kc * 256 + kq * 64) * 64 + n;
      float a = 0.f;
#pragma unroll 32
      for (int k = 0; k < 64; ++k) a += pe[k] * w1[(size_t)k * 64];
      red[kq * 64 + n] = a;
      __syncthreads();
      if (tid < 64) CB[(it * 8 + kc) * 64 + tid] = red[tid] + red[64 + tid] + red[128 + tid] + red[192 + tid];
    }
  }
  convert_layer_weights(P, 0, smf);
}

DI void phase0b(const Params& P) {
  const float* MODS = (const float*)(P.ws + OFF_MODS);
  u16* H = (u16*)(P.ws + OFF_H);
  const size_t gt = (size_t)blockIdx.x * 256 + otid(), gs = (size_t)gridDim.x * 256;
  for (size_t i = gt; i < (size_t)T * 128; i += gs) {
    const size_t t = i >> 7;
    const int d0 = (int)(i & 127) * 8;
    const int b = (int)(t >> 12);
    const float* md = MODS + (size_t)b * 6144;
    const float4 a = *(const float4*)(P.x + t * 1024 + d0), c = *(const float4*)(P.x + t * 1024 + d0 + 4);
    const float xv[8] = {a.x, a.y, a.z, a.w, c.x, c.y, c.z, c.w};
    float hv[8];
#pragma unroll
    for (int j = 0; j < 8; ++j) hv[j] = xv[j] * (1.f + md[1024 + d0 + j]) + md[d0 + j];
    *(uint4*)(H + t * 1024 + d0) = make_uint4(pk2(hv[0], hv[1]), pk2(hv[2], hv[3]), pk2(hv[4], hv[5]), pk2(hv[6], hv[7]));
  }
}

DI void phase_gemm1(const Params& P, int l, char* smraw) {
  const u16* H = (const u16*)(P.ws + OFF_H);
  const u16* W = (const u16*)(P.ws + OFF_WIN) + (size_t)l * NPAD * 1024;
  const float* ROPE = (const float*)(P.ws + OFF_ROPE);
  u16* Q = (u16*)(P.ws + OFF_Q);
  u16* KV0 = (u16*)(P.ws + OFF_KV0);
  u16* K12 = (u16*)(P.ws + OFF_K12);
  u16* VT = (u16*)(P.ws + OFF_VT);
  float* GATE = (float*)(P.ws + OFF_GATE);
  u16* PIN = (u16*)(P.ws + OFF_PIN);
  u16* GM = (u16*)(P.ws + OFF_GM);
  {
    float* STATS = (float*)(P.ws + OFF_STATS);
    for (int i = blockIdx.x * 256 + otid(); i < T * 2; i += gridDim.x * 256) STATS[i] = 0.f;
  }
  GEMM_TILE_LOOP(16) {
    int nt, mt;
    gemm_tile(q, 16, mt, nt);
    const int m0 = mt * 128, n0 = nt * 256;
    f32x16 acc[2][4];
    ACC_ZERO(acc)
    gemm_main(H, 1024, W, 1024, 1024, m0, n0, acc, (u16*)smraw);
    const int tid = otid(), lane = tid & 63, w = tid >> 6, wm = w >> 1, wn = w & 1, r = lane & 31, h = lane >> 5;
    const int rb = m0 + wm * 64;
    const int t128 = 2 * nt + wn;
    if ((t128 < 4) || (t128 == 6) || (t128 == 8)) {
      const int rl = r & 15;
#pragma unroll
      for (int i = 0; i < 2; ++i)
#pragma unroll
        for (int e = 0; e < 16; ++e) {
          const int row = rb + 32 * i + crow(e, h);
          const int pos = row & (S - 1);
#pragma unroll
          for (int j = 0; j < 4; ++j) {
            const float v = acc[i][j][e];
            const float pr = __shfl_xor(v, 2);
            const int fi = 4 * (r & 1) + j;
            const float cs = ROPE[pos * 16 + fi], sn = ROPE[pos * 16 + 8 + fi];
            float o = v;
            if (rl < 2) o = v * cs - pr * sn;
            else if (rl < 4) o = pr * sn + v * cs;
            acc[i][j][e] = o;
          }
        }
    }
    if (t128 < 4) {
#pragma unroll
      for (int i = 0; i < 2; ++i)
#pragma unroll
        for (int e = 0; e < 16; ++e) {
          const int row = rb + 32 * i + crow(e, h);
          uint2 pk;
          pk.x = pk2(acc[i][0][e] * 0.125f, acc[i][1][e] * 0.125f);
          pk.y = pk2(acc[i][2][e] * 0.125f, acc[i][3][e] * 0.125f);
          *(uint2*)(Q + (size_t)row * 512 + t128 * 128 + 4 * r) = pk;
        }
    } else if (t128 < 10) {
      const int br = (t128 - 4) >> 1, kvsel = (t128 - 4) & 1;
      if (br == 0 || kvsel == 0) {
        u16* dst = (br == 0) ? (KV0 + kvsel * 128) : (K12 + (br - 1) * 128);
#pragma unroll
        for (int i = 0; i < 2; ++i)
#pragma unroll
          for (int e = 0; e < 16; ++e) {
            const int row = rb + 32 * i + crow(e, h);
            uint2 pk;
            pk.x = pk2(acc[i][0][e], acc[i][1][e]);
            pk.y = pk2(acc[i][2][e], acc[i][3][e]);
            *(uint2*)(dst + (size_t)row * 256 + 4 * r) = pk;
          }
      } else {
#pragma unroll
        for (int i = 0; i < 2; ++i)
#pragma unroll
          for (int j = 0; j < 4; ++j)
#pragma unroll
            for (int a = 0; a < 4; ++a) {
              const int row = rb + 32 * i + 8 * a + 4 * h;
              const int b = row >> 12, sp = row & (S - 1);
              const int g = r >> 4, d = 4 * (r & 15) + j;
              uint2 pk;
              pk.x = pk2(acc[i][j][4 * a], acc[i][j][4 * a + 1]);
              pk.y = pk2(acc[i][j][4 * a + 2], acc[i][j][4 * a + 3]);
              *(uint2*)(VT + ((size_t)(((b * 2 + (br - 1)) * 2 + g) * 64 + d)) * S + sp) = pk;
            }
      }
    } else if (t128 < 14) {
#pragma unroll
      for (int i = 0; i < 2; ++i)
#pragma unroll
        for (int e = 0; e < 16; ++e) {
          const int row = rb + 32 * i + crow(e, h);
          uint2 pk;
          pk.x = pk2(acc[i][0][e], acc[i][1][e]);
          pk.y = pk2(acc[i][2][e], acc[i][3][e]);
          *(uint2*)(PIN + (size_t)row * 512 + (t128 - 10) * 128 + 4 * r) = pk;
        }
    } else if (t128 < 30) {
#pragma unroll
      for (int i = 0; i < 2; ++i)
#pragma unroll
        for (int e = 0; e < 16; ++e) {
          const int row = rb + 32 * i + crow(e, h);
          uint2 pk;
          pk.x = pk2(sigmoidf_(acc[i][0][e]), sigmoidf_(acc[i][1][e]));
          pk.y = pk2(sigmoidf_(acc[i][2][e]), sigmoidf_(acc[i][3][e]));
          *(uint2*)(GM + (size_t)row * 2048 + (t128 - 14) * 128 + 4 * r) = pk;
        }
    } else if (t128 == 30) {
      if (r < 6) {
#pragma unroll
        for (int i = 0; i < 2; ++i)
#pragma unroll
          for (int e = 0; e < 16; ++e) {
            const int row = rb + 32 * i + crow(e, h);
            *(float4*)(GATE + (size_t)row * 24 + 4 * r) = make_float4(sigmoidf_(acc[i][0][e]), sigmoidf_(acc[i][1][e]),
                                                                    sigmoidf_(acc[i][2][e]), sigmoidf_(acc[i][3][e]));
          }
      }
    }
  }
}

DI void phase_cmp_pool(const Params& P, int l, char* smraw) {
  const int tid = otid(), lane = tid & 63, w = tid >> 6, r = lane & 31, h = lane >> 5;
  const u16* KV0 = (const u16*)(P.ws + OFF_KV0);
  const u16* W1T = (const u16*)(P.ws + OFF_W1T);
  const u16* W2T = (const u16*)(P.ws + OFF_W2T);
  const float* CB = (const float*)(P.ws + OFF_CBIAS);
  const float* ROPE = (const float*)(P.ws + OFF_ROPE);
  u16* KC = (u16*)(P.ws + OFF_KC);
  u16* VCT = (u16*)(P.ws + OFF_VCT);
  const u16* PIN = (const u16*)(P.ws + OFF_PIN);
  const u16* WPT = (const u16*)(P.ws + OFF_WPT);
  u16* OPOOL = (u16*)(P.ws + OFF_OPOOL);
  const int NCMP = 128, NPOOL = 1024;
  for (int it = blockIdx.x; it < NCMP + NPOOL; it += gridDim.x) {
    __syncthreads();
    if (it < NCMP) {
      const int ct = it & 7, g = (it >> 3) & 1, b = (it >> 4) & 3, kvsel = it >> 6;
      float* red = (float*)smraw;
      u16* G1 = (u16*)(smraw + 32768);
      const u16* w1 = W1T + (size_t)(l * 2 + kvsel) * 64 * 2048;
      int c = ct * 32 + r;
      if (c > 254) c = 254;
      const u16* abase = KV0 + ((size_t)b * S + 16 * c) * 256 + kvsel * 128 + g * 64;
      f32x16 acc0 = zero16(), acc1 = zero16();
#pragma unroll 16
      for (int ks = 0; ks < 32; ++ks) {
        const int k = w * 512 + 16 * ks + 8 * h;
        const int ll = k >> 6, d = k & 63;
        const bf16x8 a = *(const bf16x8*)(abase + (size_t)ll * 256 + d);
        const bf16x8 b0 = *(const bf16x8*)(w1 + (size_t)r * 2048 + k);
        const bf16x8 b1 = *(const bf16x8*)(w1 + (size_t)(32 + r) * 2048 + k);
        acc0 = MFMA32(a, b0, acc0);
        acc1 = MFMA32(a, b1, acc1);
      }
#pragma unroll
      for (int e = 0; e < 16; ++e) {
        red[(w * 32 + crow(e, h)) * 64 + r] = acc0[e];
        red[(w * 32 + crow(e, h)) * 64 + 32 + r] = acc1[e];
      }
      __syncthreads();
      const float* cb = CB + (l * 2 + kvsel) * 512;
#pragma unroll
      for (int i = 0; i < 8; ++i) {
        const int idx = tid + 256 * i;
        const int row = idx >> 6, col = idx & 63;
        const float bias = ((cb[col] + cb[64 + col]) + (cb[128 + col] + cb[192 + col])) +
                           ((cb[256 + col] + cb[320 + col]) + (cb[384 + col] + cb[448 + col]));
        const float v = red[idx] + red[2048 + idx] + red[4096 + idx] + red[6144 + idx] + bias;
        G1[row * 72 + col] = f2bf(gelu_tanh(v));
      }
      __syncthreads();
      if (w < 2) {
        const u16* w2 = W2T + (size_t)(l * 2 + kvsel) * 64 * 64;
        f32x16 o = zero16();
#pragma unroll
        for (int ks = 0; ks < 4; ++ks) {
          const bf16x8 a = *(const bf16x8*)(G1 + r * 72 + 16 * ks + 8 * h);
          const bf16x8 bb = *(const bf16x8*)(w2 + (size_t)(32 * w + r) * 64 + 16 * ks + 8 * h);
          o = MFMA32(a, bb, o);
        }
        const int n = 32 * w + r;
        if (kvsel == 0) {
#pragma unroll
          for (int e = 0; e < 16; ++e) {
            const int cc = ct * 32 + crow(e, h);
            float v = o[e];
            const float pr = __shfl_xor(v, 8);
            if (w == 0 && r < 16) {
              const int pos = (16 * cc + 31) & (S - 1);
              const float cs = ROPE[pos * 16 + (r & 7)], sn = ROPE[pos * 16 + 8 + (r & 7)];
              v = (r < 8) ? (v * cs - pr * sn) : (pr * sn + v * cs);
            }
            if (cc > 254) v = 0.f;
            KC[((size_t)(b * 2 + g) * 256 + cc) * 64 + n] = f2bf(v);
          }
        } else {
#pragma unroll
          for (int a = 0; a < 4; ++a) {
            const int cc = ct * 32 + 8 * a + 4 * h;
            float v0 = o[4 * a], v1 = o[4 * a + 1], v2 = o[4 * a + 2], v3 = o[4 * a + 3];
            if (cc + 3 > 254) v3 = 0.f;
            uint2 pk;
            pk.x = pk2(v0, v1);
            pk.y = pk2(v2, v3);
            *(uint2*)(VCT + ((size_t)(b * 2 + g) * 64 + n) * 256 + cc) = pk;
          }
        }
      }
    } else {
      const int pi = it - NCMP;
      const int g = pi & 3, tt = pi >> 2;
      const int t0 = tt * 64;
      const int s0 = t0 & (S - 1);
      u16* Pl = (u16*)smraw;
      {
        const int c = tid & 127, half = tid >> 7;
        const int win = 2 << g;
        const u16* pc = PIN + (size_t)(t0 - s0) * 512 + g * 128 + c;
        const int sp0 = s0 + half * 32;
        float sum = 0.f;
        for (int u = sp0 - win; u < sp0; ++u)
          if (u >= 0) sum += bf2f(pc[(size_t)u * 512]);
#pragma unroll 1
        for (int k0 = 0; k0 < 32; k0 += 16) {
          float pv[16], po[16];
#pragma unroll
          for (int k = 0; k < 16; ++k) {
            const int sp = sp0 + k0 + k;
            pv[k] = bf2f(pc[(size_t)sp * 512]);
            po[k] = (sp - win >= 0) ? bf2f(pc[(size_t)(sp - win) * 512]) : 0.f;
          }
#pragma unroll
          for (int k = 0; k < 16; ++k) {
            const int sp = sp0 + k0 + k;
            sum += pv[k];
            sum -= po[k];
            const float cnt = (float)((sp + 1 < win) ? (sp + 1) : win);
            Pl[(half * 32 + k0 + k) * 136 + c] = f2bf(sum / cnt - pv[k]);
          }
        }
      }
      __syncthreads();
      const u16* wp = WPT + (size_t)(l * 4 + g) * 128 * 128;
      f32x16 a0 = zero16(), a1 = zero16();
#pragma unroll
      for (int ks = 0; ks < 8; ++ks) {
        const bf16x8 bb = *(const bf16x8*)(wp + (size_t)(32 * w + r) * 128 + 16 * ks + 8 * h);
        const bf16x8 x0 = *(const bf16x8*)(Pl + r * 136 + 16 * ks + 8 * h);
        const bf16x8 x1 = *(const bf16x8*)(Pl + (32 + r) * 136 + 16 * ks + 8 * h);
        a0 = MFMA32(x0, bb, a0);
        a1 = MFMA32(x1, bb, a1);
      }
      const int n = g * 128 + 32 * w + r;
      const float psc = P.pool_scale[l * 512 + n];
#pragma unroll
      for (int e = 0; e < 16; ++e) {
        OPOOL[(size_t)(t0 + crow(e, h)) * 512 + n] = f2bf(a0[e] * psc);
        OPOOL[(size_t)(t0 + 32 + crow(e, h)) * 512 + n] = f2bf(a1[e] * psc);
      }
    }
  }
}

struct TileRegs { u32x4 k[2], v[2]; };
DI void tile_gload(TileRegs& t, const u16* Kb, size_t ks, const u16* Vb, size_t vs, int tid_) {
  const int tid = otid();
#pragma unroll
  for (int i = 0; i < 2; ++i) {
    const int c = tid + 256 * i, row = c >> 3, c8 = (c & 7) * 8;
    t.k[i] = *(const u32x4*)(Kb + (size_t)row * ks + c8);
    t.v[i] = *(const u32x4*)(Vb + (size_t)row * vs + c8);
  }
}
DI void tile_sstore(const TileRegs& t, u16* Kb, u16* Vb, int tid_) {
  const int tid = otid();
#pragma unroll
  for (int i = 0; i < 2; ++i) {
    const int c = tid + 256 * i, row = c >> 3, c8 = (c & 7) * 8;
    *(u32x4*)(Kb + row * 72 + c8) = t.k[i];
    *(u32x4*)(Vb + row * 72 + c8) = t.v[i];
  }
}

template <int MODE>
DI void attn_step(const u16* Kb, const u16* Vb, const bf16x8 (&qf)[4], f32x16 (&o)[2], float& m, float& l, int hi, int lo,
                  bool act) {
  const int ln_ = otid() & 63, r = ln_ & 31, h = ln_ >> 5;
  f32x16 s[2];
  s[0] = zero16();
  s[1] = zero16();
#pragma unroll
  for (int ks = 0; ks < 4; ++ks) {
    const bf16x8 k0 = *(const bf16x8*)(Kb + r * 72 + 16 * ks + 8 * h);
    const bf16x8 k1 = *(const bf16x8*)(Kb + (32 + r) * 72 + 16 * ks + 8 * h);
    s[0] = MFMA32(k0, qf[ks], s[0]);
    s[1] = MFMA32(k1, qf[ks], s[1]);
  }
  float mx = -1e30f;
#pragma unroll
  for (int mt = 0; mt < 2; ++mt)
#pragma unroll
    for (int e = 0; e < 16; ++e) {
      float sv = s[mt][e];
      const int kc = 32 * mt + (e & 3) + 8 * (e >> 2);
      if (MODE & 1) sv = (kc <= hi) ? sv : -1e30f;
      if (MODE & 2) sv = (kc >= lo) ? sv : -1e30f;
      s[mt][e] = sv;
      mx = fmaxf(mx, sv);
    }
  mx = xh_max(mx);
  if (MODE & 4) mx = act ? mx : -1e30f;
  const float mnew = fmaxf(m, mx);
  const float alpha = ex2((m - mnew) * L2E);
  m = mnew;
  float mL = fmaxf(mnew, -1e20f) * L2E;
  if (MODE & 4) mL = act ? mL : 1e30f;
  if (__builtin_amdgcn_ballot_w64(alpha != 1.f)) {
#pragma unroll
    for (int dt = 0; dt < 2; ++dt)
#pragma unroll
      for (int e = 0; e < 16; ++e) o[dt][e] *= alpha;
  }
  bf16x8 av[2][2][2];
#pragma unroll
  for (int mt = 0; mt < 2; ++mt)
#pragma unroll
    for (int s2 = 0; s2 < 2; ++s2)
#pragma unroll
      for (int dt = 0; dt < 2; ++dt) {
        const u16* vp = Vb + (32 * dt + r) * 72 + 32 * mt + 16 * s2 + 4 * h;
        const s16x4 lo4 = *(const s16x4*)vp;
        const s16x4 hi4 = *(const s16x4*)(vp + 8);
        av[mt][s2][dt] = __builtin_shufflevector(lo4, hi4, 0, 1, 2, 3, 4, 5, 6, 7);
      }
  float rs = 0.f;
#pragma unroll
  for (int mt = 0; mt < 2; ++mt)
#pragma unroll
    for (int s2 = 0; s2 < 2; ++s2) {
      float p[8];
#pragma unroll
      for (int e = 0; e < 8; ++e) {
        p[e] = ex2(fmaf(s[mt][8 * s2 + e], L2E, -mL));
        rs += p[e];
      }
      u32x4 u;
      u.x = pk2(p[0], p[1]);
      u.y = pk2(p[2], p[3]);
      u.z = pk2(p[4], p[5]);
      u.w = pk2(p[6], p[7]);
      const bf16x8 pb = __builtin_bit_cast(bf16x8, u);
      o[0] = MFMA32(av[mt][s2][0], pb, o[0]);
      o[1] = MFMA32(av[mt][s2][1], pb, o[1]);
      __builtin_amdgcn_sched_barrier(0);
    }
  rs += __shfl_xor(rs, 32);
  l = l * alpha + rs;
}

template <int WM>
DI void attn_flush(const Params& P, f32x16 (&o)[2], float& m, float& l, unsigned (&pacc)[16], int tq0, int g, int br) {
  const int tid = otid(), lane = tid & 63, w = tid >> 6, r = lane & 31, h = lane >> 5;
  const float* GATE = (const float*)(P.ws + OFF_GATE);
  u16* OATT = (u16*)(P.ws + OFF_OATT);
  const int head = g * 4 + w;
  const size_t t = (size_t)tq0 + r;
  const float inv = (l > 0.f) ? (1.f / l) : 0.f;
  const float sc = inv * GATE[t * 24 + g * 12 + w * 3 + br];
#pragma unroll
  for (int dt = 0; dt < 2; ++dt)
#pragma unroll
    for (int a = 0; a < 4; ++a) {
      float v0 = o[dt][4 * a] * sc, v1 = o[dt][4 * a + 1] * sc, v2 = o[dt][4 * a + 2] * sc, v3 = o[dt][4 * a + 3] * sc;
      const int pi = (dt * 4 + a) * 2;
      if (WM >= 1) {
        v0 += bflo(pacc[pi]); v1 += bfhi(pacc[pi]); v2 += bflo(pacc[pi + 1]); v3 += bfhi(pacc[pi + 1]);
      }
      const unsigned p0 = pk2(v0, v1), p1 = pk2(v2, v3);
      if (WM <= 1) {
        pacc[pi] = p0;
        pacc[pi + 1] = p1;
      } else {
        const size_t idx = t * 512 + head * 64 + 32 * dt + 8 * a + 4 * h;
        uint2 pk;
        pk.x = p0;
        pk.y = p1;
        *(uint2*)(OATT + idx) = pk;
      }
    }
  m = -1e30f;
  l = 0.f;
  o[0] = zero16();
  o[1] = zero16();
}

DI void phase_attn_items(const Params& P, char* smraw) {
  const u16* Q = (const u16*)(P.ws + OFF_Q);
  const u16* K12 = (const u16*)(P.ws + OFF_K12);
  const u16* VT = (const u16*)(P.ws + OFF_VT);
  const u16* KC = (const u16*)(P.ws + OFF_KC);
  const u16* VCT = (const u16*)(P.ws + OFF_VCT);
  u16* Ks = (u16*)smraw;
  u16* Vs = Ks + 2 * 64 * 72;
  float* imp = (float*)(smraw + 36864);
  unsigned* selm = (unsigned*)(smraw + 36864 + 8192);
  unsigned* uni = selm + 64;
  for (int pp = blockIdx.x; pp < 1024; pp += gridDim.x) {
    const int phalf = pp & 511;
    const int item = (pp < 512) ? phalf : (1016 - (phalf & ~7) + (phalf & 7));
    const int tid = otid(), lane = tid & 63, w = tid >> 6, r = lane & 31, h = lane >> 5;
    const int cur = 63 - (item >> 4);
    const int half = (item >> 3) & 1, b = (item >> 1) & 3, g = item & 1;
    const int qi = 32 * half + r;
    const int tq0 = b * S + cur * 64 + 32 * half;
    const int head = g * 4 + w;
    __syncthreads();
    for (int i = tid; i < 2048; i += 256) imp[i] = 0.f;
    if (tid < 2) uni[tid] = 0u;
    bf16x8 qf[4];
#pragma unroll
    for (int ks = 0; ks < 4; ++ks)
      qf[ks] = *(const bf16x8*)(Q + (size_t)(tq0 + r) * 512 + head * 64 + 16 * ks + 8 * h);
    f32x16 o[2];
    o[0] = zero16();
    o[1] = zero16();
    float m = -1e30f, l = 0.f;
    TileRegs tr;
    const int nct = ((4 * cur + 2) >> 6) + 1;
    const u16* kcb = KC + (size_t)(b * 2 + g) * 256 * 64;
    const u16* vcb = VCT + (size_t)(b * 2 + g) * 64 * 256;
    const int hcmp = ((cur * 64 + qi - 31) >> 4) - 4 * h;
    int buf = 0;
    tile_gload(tr, kcb, 64, vcb, 256, tid);
    __syncthreads();
    tile_sstore(tr, Ks, Vs, tid);
    __syncthreads();
    for (int i = 0; i < nct; ++i) {
      if (i + 1 < nct) tile_gload(tr, kcb + (size_t)(i + 1) * 64 * 64, 64, vcb + (i + 1) * 64, 256, tid);
      __builtin_amdgcn_sched_barrier(0);
      attn_step<1>(Ks + buf * 4608, Vs + buf * 4608, qf, o, m, l, hcmp - 64 * i, 0, true);
      if (i + 1 < nct) tile_sstore(tr, Ks + (buf ^ 1) * 4608, Vs + (buf ^ 1) * 4608, tid);
      __syncthreads();
      buf ^= 1;
    }
    const float cm = fmaxf(m, -1e20f) * L2E;
    const float cinv = (l > 0.f) ? (1.f / l) : 0.f;
    unsigned pacc[16];
    attn_flush<0>(P, o, m, l, pacc, tq0, g, 0);
    tile_gload(tr, kcb, 64, vcb, 256, tid);
    tile_sstore(tr, Ks + buf * 4608, Vs + buf * 4608, tid);
    __syncthreads();
    for (int i = 0; i < nct; ++i) {
      if (i + 1 < nct) tile_gload(tr, kcb + (size_t)(i + 1) * 64 * 64, 64, vcb + (i + 1) * 64, 256, tid);
      __builtin_amdgcn_sched_barrier(0);
      {
        const u16* Kb = Ks + buf * 4608;
        f32x16 s[2];
        s[0] = zero16();
        s[1] = zero16();
#pragma unroll
        for (int ks = 0; ks < 4; ++ks) {
          const bf16x8 k0 = *(const bf16x8*)(Kb + r * 72 + 16 * ks + 8 * h);
          const bf16x8 k1 = *(const bf16x8*)(Kb + (32 + r) * 72 + 16 * ks + 8 * h);
          s[0] = MFMA32(k0, qf[ks], s[0]);
          s[1] = MFMA32(k1, qf[ks], s[1]);
        }
        const int hq = hcmp - 64 * i;
#pragma unroll
        for (int mt = 0; mt < 2; ++mt)
#pragma unroll
          for (int a = 0; a < 4; ++a) {
            float p[4];
#pragma unroll
            for (int q = 0; q < 4; ++q) {
              const int kc = 32 * mt + 8 * a + q;
              const float pv = ex2(fmaf(s[mt][4 * a + q], L2E, -cm)) * cinv;
              p[q] = (kc <= hq) ? pv : 0.f;
            }
            const int j = 16 * i + 8 * mt + 2 * a + h;
            atomicAdd(&imp[j * 32 + r], 2.f * (p[0] + p[1] + p[2]) + p[3]);
            if (j + 1 < 64) atomicAdd(&imp[(j + 1) * 32 + r], p[3]);
          }
      }
      if (i + 1 < nct) tile_sstore(tr, Ks + (buf ^ 1) * 4608, Vs + (buf ^ 1) * 4608, tid);
      __syncthreads();
      buf ^= 1;
    }
    {
      const int q = 8 * w + (lane & 7), part = lane >> 3;
      unsigned long long mask;
      if (cur <= 15) {
        mask = (2ULL << cur) - 1ULL;
      } else {
        mask = 1ULL | (1ULL << cur);
        for (int itn = 0; itn < 14; ++itn) {
          unsigned best = 0u;
#pragma unroll
          for (int jj = 0; jj < 8; ++jj) {
            const int j = part * 8 + jj;
            const unsigned k = (__float_as_uint(imp[j * 32 + q]) & ~63u) | (unsigned)(63 - j);
            const bool ok = (j >= 1) && (j < cur) && !((mask >> j) & 1ULL);
            best = umax_(best, ok ? k : 0u);
          }
          best = umax_(best, shx(best, 8));
          best = umax_(best, shx(best, 16));
          best = umax_(best, shx(best, 32));
          mask |= 1ULL << (63 - (int)(best & 63u));
        }
      }
      if (part == 0) {
        selm[q * 2] = (unsigned)mask;
        selm[q * 2 + 1] = (unsigned)(mask >> 32);
        atomicOr(&uni[0], (unsigned)mask);
        atomicOr(&uni[1], (unsigned)(mask >> 32));
      }
    }
    __syncthreads();
    unsigned long long um = ((unsigned long long)uni[1] << 32) | uni[0];
    um &= (2ULL << cur) - 1ULL;
    const unsigned long long qm = ((unsigned long long)selm[r * 2 + 1] << 32) | selm[r * 2];
    {
      const u16* kb = K12 + (size_t)(b * S) * 256 + 0 * 128 + g * 64;
      const u16* vb = VT + (size_t)((b * 2 + 0) * 2 + g) * 64 * S;
      int j = __ffsll((long long)um) - 1;
      tile_gload(tr, kb + (size_t)(j * 64) * 256, 256, vb + j * 64, S, tid);
      tile_sstore(tr, Ks + buf * 4608, Vs + buf * 4608, tid);
      __syncthreads();
      while (true) {
        um &= um - 1ULL;
        const int jn = um ? (__ffsll((long long)um) - 1) : -1;
        if (jn >= 0) tile_gload(tr, kb + (size_t)(jn * 64) * 256, 256, vb + jn * 64, S, tid);
        __builtin_amdgcn_sched_barrier(0);
        if (j == cur) {
          attn_step<1>(Ks + buf * 4608, Vs + buf * 4608, qf, o, m, l, qi - 4 * h, 0, true);
        } else {
          attn_step<4>(Ks + buf * 4608, Vs + buf * 4608, qf, o, m, l, 0, 0, (bool)((qm >> j) & 1ULL));
        }
        if (jn >= 0) tile_sstore(tr, Ks + (buf ^ 1) * 4608, Vs + (buf ^ 1) * 4608, tid);
        __syncthreads();
        buf ^= 1;
        if (jn < 0) break;
        j = jn;
      }
      attn_flush<1>(P, o, m, l, pacc, tq0, g, 1);
    }
    {
      const u16* kb = K12 + (size_t)(b * S) * 256 + 1 * 128 + g * 64;
      const u16* vb = VT + (size_t)((b * 2 + 1) * 2 + g) * 64 * S;
      const int j0 = (cur - 8 > 0) ? (cur - 8) : 0;
      tile_gload(tr, kb + (size_t)(j0 * 64) * 256, 256, vb + j0 * 64, S, tid);
      tile_sstore(tr, Ks + buf * 4608, Vs + buf * 4608, tid);
      __syncthreads();
      for (int j = j0; j <= cur; ++j) {
        if (j + 1 <= cur) tile_gload(tr, kb + (size_t)((j + 1) * 64) * 256, 256, vb + (j + 1) * 64, S, tid);
        __builtin_amdgcn_sched_barrier(0);
        if (j == cur) {
          attn_step<1>(Ks + buf * 4608, Vs + buf * 4608, qf, o, m, l, qi - 4 * h, 0, true);
        } else if (j == cur - 8) {
          attn_step<2>(Ks + buf * 4608, Vs + buf * 4608, qf, o, m, l, 0, qi + 1 - 4 * h, true);
        } else {
          attn_step<0>(Ks + buf * 4608, Vs + buf * 4608, qf, o, m, l, 0, 0, true);
        }
        if (j + 1 <= cur) tile_sstore(tr, Ks + (buf ^ 1) * 4608, Vs + (buf ^ 1) * 4608, tid);
        __syncthreads();
        buf ^= 1;
      }
      attn_flush<2>(P, o, m, l, pacc, tq0, g, 2);
    }
  }
}

#define EPI_IDS const int tid = otid(), lane = tid & 63, w = tid >> 6, wm = w >> 1, wn = w & 1, r = lane & 31, h = lane >> 5;
#define EPI_ROWS                                      \
  _Pragma("unroll") for (int i = 0; i < 2; ++i)       \
  _Pragma("unroll") for (int e = 0; e < 16; ++e)

DI void phase_gemm2_pool(const Params& P, int l, char* smraw) {
  const u16* OPOOL = (const u16*)(P.ws + OFF_OPOOL);
  const u16* L1 = (const u16*)(P.ws + OFF_LIFT) + (size_t)(l * 2 + 1) * 1024 * 512;
  const u16* GM = (const u16*)(P.ws + OFF_GM);
  u16* MERGED = (u16*)(P.ws + OFF_MERGED);
  GEMM_TILE_LOOP(4) {
    int nt, mt;
    gemm_tile(q, 4, mt, nt);
    const int m0 = mt * 128, n0 = nt * 256;
    f32x16 acc[2][4];
    ACC_ZERO(acc)
    gemm_main(OPOOL, 512, L1, 512, 512, m0, n0, acc, (u16*)smraw);
    {
      EPI_IDS
      EPI_ROWS {
        const int row = m0 + wm * 64 + 32 * i + crow(e, h), col = n0 + wn * 128 + 4 * r;
        const uint2 gv = *(const uint2*)(GM + (size_t)row * 2048 + 1024 + col);
        uint2 pk;
        pk.x = pk2(acc[i][0][e] * bflo(gv.x), acc[i][1][e] * bfhi(gv.x));
        pk.y = pk2(acc[i][2][e] * bflo(gv.y), acc[i][3][e] * bfhi(gv.y));
        *(uint2*)(MERGED + (size_t)row * 1024 + col) = pk;
      }
    }
  }
  __syncthreads();
}

DI void phase_gemm2(const Params& P, int l, char* smraw) {
  const u16* OATT = (const u16*)(P.ws + OFF_OATT);
  const u16* L0 = (const u16*)(P.ws + OFF_LIFT) + (size_t)(l * 2 + 0) * 1024 * 512;
  const u16* GM = (const u16*)(P.ws + OFF_GM);
  u16* MERGED = (u16*)(P.ws + OFF_MERGED);
  GEMM_TILE_LOOP(4) {
    int nt, mt;
    gemm_tile(q, 4, mt, nt);
    const int m0 = mt * 128, n0 = nt * 256;
    f32x16 acc[2][4];
    ACC_ZERO(acc)
    gemm_main(OATT, 512, L0, 512, 512, m0, n0, acc, (u16*)smraw);
    {
      EPI_IDS
      EPI_ROWS {
        const int row = m0 + wm * 64 + 32 * i + crow(e, h), col = n0 + wn * 128 + 4 * r;
        const uint2 gv = *(const uint2*)(GM + (size_t)row * 2048 + col);
        const uint2 mv = *(const uint2*)(MERGED + (size_t)row * 1024 + col);
        uint2 pk;
        pk.x = pk2(bflo(mv.x) + acc[i][0][e] * bflo(gv.x), bfhi(mv.x) + acc[i][1][e] * bfhi(gv.x));
        pk.y = pk2(bflo(mv.y) + acc[i][2][e] * bflo(gv.y), bfhi(mv.y) + acc[i][3][e] * bfhi(gv.y));
        *(uint2*)(MERGED + (size_t)row * 1024 + col) = pk;
      }
    }
  }
}

DI void phase_attn(const Params& P, int l, char* smraw) {
  const bool side_first = (blockIdx.x >> 8) & 1;
  if (side_first) {
    phase_gemm2_pool(P, l, smraw);
    convert_layer_peer(P, l);
    if (l + 1 < NL) convert_layer_weights(P, l + 1, (float*)smraw);
  }
  phase_attn_items(P, smraw);
  if (!side_first) {
    __syncthreads();
    phase_gemm2_pool(P, l, smraw);
    convert_layer_peer(P, l);
    if (l + 1 < NL) convert_layer_weights(P, l + 1, (float*)smraw);
  }
}

DI float xsum32(float (&p)[32], int lane) {
  float q16[16], q8[8], q4[4], q2[2];
  const bool b16 = lane & 16, b8 = lane & 8, b4 = lane & 4, b2 = lane & 2, b1 = lane & 1;
#pragma unroll
  for (int i = 0; i < 16; ++i) { const float k = b16 ? p[16 + i] : p[i], sd = b16 ? p[i] : p[16 + i]; q16[i] = k + __shfl_xor(sd, 16); }
#pragma unroll
  for (int i = 0; i < 8; ++i) { const float k = b8 ? q16[8 + i] : q16[i], sd = b8 ? q16[i] : q16[8 + i]; q8[i] = k + __shfl_xor(sd, 8); }
#pragma unroll
  for (int i = 0; i < 4; ++i) { const float k = b4 ? q8[4 + i] : q8[i], sd = b4 ? q8[i] : q8[4 + i]; q4[i] = k + __shfl_xor(sd, 4); }
#pragma unroll
  for (int i = 0; i < 2; ++i) { const float k = b2 ? q4[2 + i] : q4[i], sd = b2 ? q4[i] : q4[2 + i]; q2[i] = k + __shfl_xor(sd, 2); }
  const float k = b1 ? q2[1] : q2[0], sd = b1 ? q2[0] : q2[1];
  return k + __shfl_xor(sd, 1);
}

DI void phase_gemm3(const Params& P, int l, char* smraw) {
  const u16* MERGED = (const u16*)(P.ws + OFF_MERGED);
  const u16* WO = (const u16*)(P.ws + OFF_WO) + (size_t)l * 1024 * 1024;
  const float* MODS = (const float*)(P.ws + OFF_MODS);
  const float* Xs = (l == 0) ? P.x : (const float*)(P.ws + OFF_X);
  float* X = (float*)(P.ws + OFF_X);
  u16* H = (u16*)(P.ws + OFF_H);
  float* STATS = (float*)(P.ws + OFF_STATS);
  unsigned* MTC = (unsigned*)(P.ws + OFF_BAR) + MT_CNT_WORD;
  GEMM_TILE_LOOP(4) {
    int nt, mt;
    gemm_tile(q, 4, mt, nt);
    const int m0 = mt * 128, n0 = nt * 256;
    f32x16 acc[2][4];
    ACC_ZERO(acc)
#if DO_MIXER
    gemm_main(MERGED, 1024, WO, 1024, 1024, m0, n0, acc, (u16*)smraw);
#endif
    const int b = m0 >> 12;
    const float* md = MODS + (size_t)(l * 4 + b) * 6144;
    const int tid = otid(), lane = tid & 63, w = tid >> 6, wm = w >> 1, wn = w & 1, r = lane & 31, h = lane >> 5;
    const int cb = n0 + wn * 128 + 4 * r;
    {
      const float4 g1v = *(const float4*)(md + 2048 + cb);
#pragma unroll
      for (int i = 0; i < 2; ++i)
#pragma unroll
        for (int e = 0; e < 16; ++e) {
          const unsigned off = (unsigned)((m0 + wm * 64 + 32 * i + crow(e, h)) * 1024 + cb);
          const float4 xv = *(const float4*)(Xs + off);
          acc[i][0][e] = DN_ALPHA * xv.x + g1v.x * acc[i][0][e];
          acc[i][1][e] = DN_ALPHA * xv.y + g1v.y * acc[i][1][e];
          acc[i][2][e] = DN_ALPHA * xv.z + g1v.z * acc[i][2][e];
          acc[i][3][e] = DN_ALPHA * xv.w + g1v.w * acc[i][3][e];
          if ((e & 7) == 7) __builtin_amdgcn_sched_barrier(0);
        }
    }
    {
      float ts, tq;
      {
        float ps[32];
#pragma unroll
        for (int i = 0; i < 2; ++i)
#pragma unroll
          for (int e = 0; e < 16; ++e) ps[i * 16 + e] = (acc[i][0][e] + acc[i][1][e]) + (acc[i][2][e] + acc[i][3][e]);
        ts = xsum32(ps, lane);
      }
      __builtin_amdgcn_sched_barrier(0);
      {
        float pq[32];
#pragma unroll
        for (int i = 0; i < 2; ++i)
#pragma unroll
          for (int e = 0; e < 16; ++e)
            pq[i * 16 + e] = (acc[i][0][e] * acc[i][0][e] + acc[i][1][e] * acc[i][1][e]) +
                             (acc[i][2][e] * acc[i][2][e] + acc[i][3][e] * acc[i][3][e]);
        tq = xsum32(pq, lane);
      }
      __builtin_amdgcn_sched_barrier(0);
      const int row = m0 + wm * 64 + 32 * (r >> 4) + crow(r & 15, h);
      atomicAdd(&STATS[(size_t)row * 2], ts);
      atomicAdd(&STATS[(size_t)row * 2 + 1], tq);
    }
    asm volatile("s_waitcnt vmcnt(0)" ::: "memory");
    __syncthreads();
    if (otid() == 0) {
      __hip_atomic_fetch_add(&MTC[mt], 1u, __ATOMIC_RELEASE, __HIP_MEMORY_SCOPE_AGENT);
      const unsigned target = 4u * (unsigned)(l + 1);
      unsigned spins = 0;
      while (__hip_atomic_load(&MTC[mt], __ATOMIC_ACQUIRE, __HIP_MEMORY_SCOPE_AGENT) < target) {
        __builtin_amdgcn_s_sleep(1);
        if (++spins > (1u << 22)) break;
      }
    }
    __syncthreads();
    {
      const int tid2 = otid(), lane2 = tid2 & 63, w2 = tid2 >> 6, wm = w2 >> 1, wn = w2 & 1, r = lane2 & 31, h = lane2 >> 5;
      const int cb = n0 + wn * 128 + 4 * r;
      const float4 gm4 = *(const float4*)(P.ln_g + (size_t)(l * 2 + 0) * 1024 + cb);
      const float4 bt4 = *(const float4*)(P.ln_b + (size_t)(l * 2 + 0) * 1024 + cb);
      const float4 sh4 = *(const float4*)(md + 3072 + cb);
      const float4 sc4 = *(const float4*)(md + 4096 + cb);
#pragma unroll
      for (int i = 0; i < 2; ++i)
#pragma unroll
        for (int e = 0; e < 16; ++e) {
          const int row = m0 + wm * 64 + 32 * i + crow(e, h);
          const float sm_ = __hip_atomic_load(&STATS[(size_t)row * 2], __ATOMIC_RELAXED, __HIP_MEMORY_SCOPE_AGENT);
          const float sq_ = __hip_atomic_load(&STATS[(size_t)row * 2 + 1], __ATOMIC_RELAXED, __HIP_MEMORY_SCOPE_AGENT);
          const float mu = sm_ * (1.f / 1024.f);
          const float var = fmaxf(sq_ * (1.f / 1024.f) - mu * mu, 0.f);
          const float rstd = rsqrtf(var + 1e-5f);
          const float x0 = (acc[i][0][e] - mu) * rstd * gm4.x + bt4.x;
          const float x1 = (acc[i][1][e] - mu) * rstd * gm4.y + bt4.y;
          const float x2 = (acc[i][2][e] - mu) * rstd * gm4.z + bt4.z;
          const float x3 = (acc[i][3][e] - mu) * rstd * gm4.w + bt4.w;
          const unsigned idx = (unsigned)(row * 1024 + cb);
          *(float4*)(X + idx) = make_float4(x0, x1, x2, x3);
          uint2 pk;
          pk.x = pk2(x0 * (1.f + sc4.x) + sh4.x, x1 * (1.f + sc4.y) + sh4.y);
          pk.y = pk2(x2 * (1.f + sc4.z) + sh4.z, x3 * (1.f + sc4.w) + sh4.w);
          *(uint2*)(H + idx) = pk;
        }
    }
  }
}

template <int LAYOUT>
DI void ln_finish(float (&v)[16], size_t t, int lane, const float* gam, const float* bet, const float* sh,
                  const float* sc, float* Xo, u16* Ho) {
  float s = 0.f;
#pragma unroll
  for (int i = 0; i < 16; ++i) s += v[i];
  s = wsum(s);
  const float mu = s * (1.f / 1024.f);
  float q = 0.f;
#pragma unroll
  for (int i = 0; i < 16; ++i) { const float d = v[i] - mu; q += d * d; }
  q = wsum(q);
  const float rstd = rsqrtf(q * (1.f / 1024.f) + 1e-5f);
#pragma unroll
  for (int half = 0; half < 2; ++half) {
    const int d0 = LAYOUT ? (lane * 16 + half * 8) : (half * 512 + lane * 8);
    float y[8];
#pragma unroll
    for (int i = 0; i < 8; ++i) y[i] = (v[half * 8 + i] - mu) * rstd * gam[d0 + i] + bet[d0 + i];
    *(float4*)(Xo + t * 1024 + d0) = make_float4(y[0], y[1], y[2], y[3]);
    *(float4*)(Xo + t * 1024 + d0 + 4) = make_float4(y[4], y[5], y[6], y[7]);
    if (Ho) {
      float hv[8];
#pragma unroll
      for (int i = 0; i < 8; ++i) hv[i] = y[i] * (1.f + sc[d0 + i]) + sh[d0 + i];
      *(uint4*)(Ho + t * 1024 + d0) = make_uint4(pk2(hv[0], hv[1]), pk2(hv[2], hv[3]), pk2(hv[4], hv[5]), pk2(hv[6], hv[7]));
    }
  }
}

DI void phase_ln1(const Params& P, int l) {
  const int tid_ = otid(); const int lane = tid_ & 63, w = tid_ >> 6;
  const float* R = (const float*)(P.ws + OFF_R);
  const float* MODS = (const float*)(P.ws + OFF_MODS);
  float* X = (float*)(P.ws + OFF_X);
  u16* H = (u16*)(P.ws + OFF_H);
  for (int t = blockIdx.x * 4 + w; t < T; t += gridDim.x * 4) {
    float v[16];
#pragma unroll
    for (int half = 0; half < 2; ++half) {
      const float4 a = *(const float4*)(R + (size_t)t * 1024 + half * 512 + lane * 8);
      const float4 c = *(const float4*)(R + (size_t)t * 1024 + half * 512 + lane * 8 + 4);
      v[half * 8 + 0] = a.x; v[half * 8 + 1] = a.y; v[half * 8 + 2] = a.z; v[half * 8 + 3] = a.w;
      v[half * 8 + 4] = c.x; v[half * 8 + 5] = c.y; v[half * 8 + 6] = c.z; v[half * 8 + 7] = c.w;
    }
    const int b = t >> 12;
    const float* md = MODS + (size_t)(l * 4 + b) * 6144;
    ln_finish<0>(v, (size_t)t, lane, P.ln_g + (size_t)(l * 2 + 0) * 1024, P.ln_b + (size_t)(l * 2 + 0) * 1024, md + 3072,
              md + 4096, X, H);
  }
}

DI void phase_gemm4(const Params& P, int l, char* smraw) {
  const u16* H = (const u16*)(P.ws + OFF_H);
  const u16* WQ = (const u16*)(P.ws + OFF_WQ) + (size_t)l * 1024 * 1024;
  u16* PQ = (u16*)(P.ws + OFF_PQ);
  GEMM_TILE_LOOP(4) {
    int nt, mt;
    gemm_tile(q, 4, mt, nt);
    const int m0 = mt * 128, n0 = nt * 256;
    f32x16 acc[2][4];
    ACC_ZERO(acc)
    gemm_main(H, 1024, WQ, 1024, 1024, m0, n0, acc, (u16*)smraw);
    EPI_IDS
    EPI_ROWS {
      const int row = m0 + wm * 64 + 32 * i + crow(e, h), col = n0 + wn * 128 + 4 * r;
      uint2 pk;
      pk.x = pk2(acc[i][0][e], acc[i][1][e]);
      pk.y = pk2(acc[i][2][e], acc[i][3][e]);
      *(uint2*)(PQ + (size_t)row * 1024 + col) = pk;
    }
  }
}

DI unsigned sortkey(float f, unsigned lowmask, unsigned lowval) {
  unsigned b = __float_as_uint(f);
  b = (b & 0x80000000u) ? ~b : (b | 0x80000000u);
  return (b & ~lowmask) | lowval;
}
DI float unsortkey(unsigned k, unsigned lowmask) {
  const unsigned b = k & ~lowmask;
  return __uint_as_float((b & 0x80000000u) ? (b & 0x7fffffffu) : ~b);
}
DI float sel4f(int g, float a, float b, float c, float d) { return g == 0 ? a : (g == 1 ? b : (g == 2 ? c : d)); }
DI int sel4i(int g, int a, int b, int c, int d) { return g == 0 ? a : (g == 1 ? b : (g == 2 ? c : d)); }

DI unsigned umin_(unsigned a, unsigned b) { return a < b ? a : b; }
DI void sort32_top16(unsigned (&v)[32]) {
  { const unsigned a_ = v[0], b_ = v[1]; v[0] = umax_(a_, b_); v[1] = umin_(a_, b_); }
  { const unsigned a_ = v[2], b_ = v[3]; v[2] = umin_(a_, b_); v[3] = umax_(a_, b_); }
  { const unsigned a_ = v[4], b_ = v[5]; v[4] = umax_(a_, b_); v[5] = umin_(a_, b_); }
  { const unsigned a_ = v[6], b_ = v[7]; v[6] = umin_(a_, b_); v[7] = umax_(a_, b_); }
  { const unsigned a_ = v[8], b_ = v[9]; v[8] = umax_(a_, b_); v[9] = umin_(a_, b_); }
  { const unsigned a_ = v[10], b_ = v[11]; v[10] = umin_(a_, b_); v[11] = umax_(a_, b_); }
  { const unsigned a_ = v[12], b_ = v[13]; v[12] = umax_(a_, b_); v[13] = umin_(a_, b_); }
  { const unsigned a_ = v[14], b_ = v[15]; v[14] = umin_(a_, b_); v[15] = umax_(a_, b_); }
  { const unsigned a_ = v[16], b_ = v[17]; v[16] = umax_(a_, b_); v[17] = umin_(a_, b_); }
  { const unsigned a_ = v[18], b_ = v[19]; v[18] = umin_(a_, b_); v[19] = umax_(a_, b_); }
  { const unsigned a_ = v[20], b_ = v[21]; v[20] = umax_(a_, b_); v[21] = umin_(a_, b_); }
  { const unsigned a_ = v[22], b_ = v[23]; v[22] = umin_(a_, b_); v[23] = umax_(a_, b_); }
  { const unsigned a_ = v[24], b_ = v[25]; v[24] = umax_(a_, b_); v[25] = umin_(a_, b_); }
  { const unsigned a_ = v[26], b_ = v[27]; v[26] = umin_(a_, b_); v[27] = umax_(a_, b_); }
  { const unsigned a_ = v[28], b_ = v[29]; v[28] = umax_(a_, b_); v[29] = umin_(a_, b_); }
  { const unsigned a_ = v[30], b_ = v[31]; v[30] = umin_(a_, b_); v[31] = umax_(a_, b_); }
  { const unsigned a_ = v[0], b_ = v[2]; v[0] = umax_(a_, b_); v[2] = umin_(a_, b_); }
  { const unsigned a_ = v[1], b_ = v[3]; v[1] = umax_(a_, b_); v[3] = umin_(a_, b_); }
  { const unsigned a_ = v[4], b_ = v[6]; v[4] = umin_(a_, b_); v[6] = umax_(a_, b_); }
  { const unsigned a_ = v[5], b_ = v[7]; v[5] = umin_(a_, b_); v[7] = umax_(a_, b_); }
  { const unsigned a_ = v[8], b_ = v[10]; v[8] = umax_(a_, b_); v[10] = umin_(a_, b_); }
  { const unsigned a_ = v[9], b_ = v[11]; v[9] = umax_(a_, b_); v[11] = umin_(a_, b_); }
  { const unsigned a_ = v[12], b_ = v[14]; v[12] = umin_(a_, b_); v[14] = umax_(a_, b_); }
  { const unsigned a_ = v[13], b_ = v[15]; v[13] = umin_(a_, b_); v[15] = umax_(a_, b_); }
  { const unsigned a_ = v[16], b_ = v[18]; v[16] = umax_(a_, b_); v[18] = umin_(a_, b_); }
  { const unsigned a_ = v[17], b_ = v[19]; v[17] = umax_(a_, b_); v[19] = umin_(a_, b_); }
  { const unsigned a_ = v[20], b_ = v[22]; v[20] = umin_(a_, b_); v[22] = umax_(a_, b_); }
  { const unsigned a_ = v[21], b_ = v[23]; v[21] = umin_(a_, b_); v[23] = umax_(a_, b_); }
  { const unsigned a_ = v[24], b_ = v[26]; v[24] = umax_(a_, b_); v[26] = umin_(a_, b_); }
  { const unsigned a_ = v[25], b_ = v[27]; v[25] = umax_(a_, b_); v[27] = umin_(a_, b_); }
  { const unsigned a_ = v[28], b_ = v[30]; v[28] = umin_(a_, b_); v[30] = umax_(a_, b_); }
  { const unsigned a_ = v[29], b_ = v[31]; v[29] = umin_(a_, b_); v[31] = umax_(a_, b_); }
  { const unsigned a_ = v[0], b_ = v[1]; v[0] = umax_(a_, b_); v[1] = umin_(a_, b_); }
  { const unsigned a_ = v[2], b_ = v[3]; v[2] = umax_(a_, b_); v[3] = umin_(a_, b_); }
  { const unsigned a_ = v[4], b_ = v[5]; v[4] = umin_(a_, b_); v[5] = umax_(a_, b_); }
  { const unsigned a_ = v[6], b_ = v[7]; v[6] = umin_(a_, b_); v[7] = umax_(a_, b_); }
  { const unsigned a_ = v[8], b_ = v[9]; v[8] = umax_(a_, b_); v[9] = umin_(a_, b_); }
  { const unsigned a_ = v[10], b_ = v[11]; v[10] = umax_(a_, b_); v[11] = umin_(a_, b_); }
  { const unsigned a_ = v[12], b_ = v[13]; v[12] = umin_(a_, b_); v[13] = umax_(a_, b_); }
  { const unsigned a_ = v[14], b_ = v[15]; v[14] = umin_(a_, b_); v[15] = umax_(a_, b_); }
  { const unsigned a_ = v[16], b_ = v[17]; v[16] = umax_(a_, b_); v[17] = umin_(a_, b_); }
  { const unsigned a_ = v[18], b_ = v[19]; v[18] = umax_(a_, b_); v[19] = umin_(a_, b_); }
  { const unsigned a_ = v[20], b_ = v[21]; v[20] = umin_(a_, b_); v[21] = umax_(a_, b_); }
  { const unsigned a_ = v[22], b_ = v[23]; v[22] = umin_(a_, b_); v[23] = umax_(a_, b_); }
  { const unsigned a_ = v[24], b_ = v[25]; v[24] = umax_(a_, b_); v[25] = umin_(a_, b_); }
  { const unsigned a_ = v[26], b_ = v[27]; v[26] = umax_(a_, b_); v[27] = umin_(a_, b_); }
  { const unsigned a_ = v[28], b_ = v[29]; v[28] = umin_(a_, b_); v[29] = umax_(a_, b_); }
  { const unsigned a_ = v[30], b_ = v[31]; v[30] = umin_(a_, b_); v[31] = umax_(a_, b_); }
  { const unsigned a_ = v[0], b_ = v[4]; v[0] = umax_(a_, b_); v[4] = umin_(a_, b_); }
  { const unsigned a_ = v[1], b_ = v[5]; v[1] = umax_(a_, b_); v[5] = umin_(a_, b_); }
  { const unsigned a_ = v[2], b_ = v[6]; v[2] = umax_(a_, b_); v[6] = umin_(a_, b_); }
  { const unsigned a_ = v[3], b_ = v[7]; v[3] = umax_(a_, b_); v[7] = umin_(a_, b_); }
  { const unsigned a_ = v[8], b_ = v[12]; v[8] = umin_(a_, b_); v[12] = umax_(a_, b_); }
  { const unsigned a_ = v[9], b_ = v[13]; v[9] = umin_(a_, b_); v[13] = umax_(a_, b_); }
  { const unsigned a_ = v[10], b_ = v[14]; v[10] = umin_(a_, b_); v[14] = umax_(a_, b_); }
  { const unsigned a_ = v[11], b_ = v[15]; v[11] = umin_(a_, b_); v[15] = umax_(a_, b_); }
  { const unsigned a_ = v[16], b_ = v[20]; v[16] = umax_(a_, b_); v[20] = umin_(a_, b_); }
  { const unsigned a_ = v[17], b_ = v[21]; v[17] = umax_(a_, b_); v[21] = umin_(a_, b_); }
  { const unsigned a_ = v[18], b_ = v[22]; v[18] = umax_(a_, b_); v[22] = umin_(a_, b_); }
  { const unsigned a_ = v[19], b_ = v[23]; v[19] = umax_(a_, b_); v[23] = umin_(a_, b_); }
  { const unsigned a_ = v[24], b_ = v[28]; v[24] = umin_(a_, b_); v[28] = umax_(a_, b_); }
  { const unsigned a_ = v[25], b_ = v[29]; v[25] = umin_(a_, b_); v[29] = umax_(a_, b_); }
  { const unsigned a_ = v[26], b_ = v[30]; v[26] = umin_(a_, b_); v[30] = umax_(a_, b_); }
  { const unsigned a_ = v[27], b_ = v[31]; v[27] = umin_(a_, b_); v[31] = umax_(a_, b_); }
  { const unsigned a_ = v[0], b_ = v[2]; v[0] = umax_(a_, b_); v[2] = umin_(a_, b_); }
  { const unsigned a_ = v[1], b_ = v[3]; v[1] = umax_(a_, b_); v[3] = umin_(a_, b_); }
  { const unsigned a_ = v[4], b_ = v[6]; v[4] = umax_(a_, b_); v[6] = umin_(a_, b_); }
  { const unsigned a_ = v[5], b_ = v[7]; v[5] = umax_(a_, b_); v[7] = umin_(a_, b_); }
  { const unsigned a_ = v[8], b_ = v[10]; v[8] = umin_(a_, b_); v[10] = umax_(a_, b_); }
  { const unsigned a_ = v[9], b_ = v[11]; v[9] = umin_(a_, b_); v[11] = umax_(a_, b_); }
  { const unsigned a_ = v[12], b_ = v[14]; v[12] = umin_(a_, b_); v[14] = umax_(a_, b_); }
  { const unsigned a_ = v[13], b_ = v[15]; v[13] = umin_(a_, b_); v[15] = umax_(a_, b_); }
  { const unsigned a_ = v[16], b_ = v[18]; v[16] = umax_(a_, b_); v[18] = umin_(a_, b_); }
  { const unsigned a_ = v[17], b_ = v[19]; v[17] = umax_(a_, b_); v[19] = umin_(a_, b_); }
  { const unsigned a_ = v[20], b_ = v[22]; v[20] = umax_(a_, b_); v[22] = umin_(a_, b_); }
  { const unsigned a_ = v[21], b_ = v[23]; v[21] = umax_(a_, b_); v[23] = umin_(a_, b_); }
  { const unsigned a_ = v[24], b_ = v[26]; v[24] = umin_(a_, b_); v[26] = umax_(a_, b_); }
  { const unsigned a_ = v[25], b_ = v[27]; v[25] = umin_(a_, b_); v[27] = umax_(a_, b_); }
  { const unsigned a_ = v[28], b_ = v[30]; v[28] = umin_(a_, b_); v[30] = umax_(a_, b_); }
  { const unsigned a_ = v[29], b_ = v[31]; v[29] = umin_(a_, b_); v[31] = umax_(a_, b_); }
  { const unsigned a_ = v[0], b_ = v[1]; v[0] = umax_(a_, b_); v[1] = umin_(a_, b_); }
  { const unsigned a_ = v[2], b_ = v[3]; v[2] = umax_(a_, b_); v[3] = umin_(a_, b_); }
  { const unsigned a_ = v[4], b_ = v[5]; v[4] = umax_(a_, b_); v[5] = umin_(a_, b_); }
  { const unsigned a_ = v[6], b_ = v[7]; v[6] = umax_(a_, b_); v[7] = umin_(a_, b_); }
  { const unsigned a_ = v[8], b_ = v[9]; v[8] = umin_(a_, b_); v[9] = umax_(a_, b_); }
  { const unsigned a_ = v[10], b_ = v[11]; v[10] = umin_(a_, b_); v[11] = umax_(a_, b_); }
  { const unsigned a_ = v[12], b_ = v[13]; v[12] = umin_(a_, b_); v[13] = umax_(a_, b_); }
  { const unsigned a_ = v[14], b_ = v[15]; v[14] = umin_(a_, b_); v[15] = umax_(a_, b_); }
  { const unsigned a_ = v[16], b_ = v[17]; v[16] = umax_(a_, b_); v[17] = umin_(a_, b_); }
  { const unsigned a_ = v[18], b_ = v[19]; v[18] = umax_(a_, b_); v[19] = umin_(a_, b_); }
  { const unsigned a_ = v[20], b_ = v[21]; v[20] = umax_(a_, b_); v[21] = umin_(a_, b_); }
  { const unsigned a_ = v[22], b_ = v[23]; v[22] = umax_(a_, b_); v[23] = umin_(a_, b_); }
  { const unsigned a_ = v[24], b_ = v[25]; v[24] = umin_(a_, b_); v[25] = umax_(a_, b_); }
  { const unsigned a_ = v[26], b_ = v[27]; v[26] = umin_(a_, b_); v[27] = umax_(a_, b_); }
  { const unsigned a_ = v[28], b_ = v[29]; v[28] = umin_(a_, b_); v[29] = umax_(a_, b_); }
  { const unsigned a_ = v[30], b_ = v[31]; v[30] = umin_(a_, b_); v[31] = umax_(a_, b_); }
  { const unsigned a_ = v[0], b_ = v[8]; v[0] = umax_(a_, b_); v[8] = umin_(a_, b_); }
  { const unsigned a_ = v[1], b_ = v[9]; v[1] = umax_(a_, b_); v[9] = umin_(a_, b_); }
  { const unsigned a_ = v[2], b_ = v[10]; v[2] = umax_(a_, b_); v[10] = umin_(a_, b_); }
  { const unsigned a_ = v[3], b_ = v[11]; v[3] = umax_(a_, b_); v[11] = umin_(a_, b_); }
  { const unsigned a_ = v[4], b_ = v[12]; v[4] = umax_(a_, b_); v[12] = umin_(a_, b_); }
  { const unsigned a_ = v[5], b_ = v[13]; v[5] = umax_(a_, b_); v[13] = umin_(a_, b_); }
  { const unsigned a_ = v[6], b_ = v[14]; v[6] = umax_(a_, b_); v[14] = umin_(a_, b_); }
  { const unsigned a_ = v[7], b_ = v[15]; v[7] = umax_(a_, b_); v[15] = umin_(a_, b_); }
  { const unsigned a_ = v[16], b_ = v[24]; v[16] = umin_(a_, b_); v[24] = umax_(a_, b_); }
  { const unsigned a_ = v[17], b_ = v[25]; v[17] = umin_(a_, b_); v[25] = umax_(a_, b_); }
  { const unsigned a_ = v[18], b_ = v[26]; v[18] = umin_(a_, b_); v[26] = umax_(a_, b_); }
  { const unsigned a_ = v[19], b_ = v[27]; v[19] = umin_(a_, b_); v[27] = umax_(a_, b_); }
  { const unsigned a_ = v[20], b_ = v[28]; v[20] = umin_(a_, b_); v[28] = umax_(a_, b_); }
  { const unsigned a_ = v[21], b_ = v[29]; v[21] = umin_(a_, b_); v[29] = umax_(a_, b_); }
  { const unsigned a_ = v[22], b_ = v[30]; v[22] = umin_(a_, b_); v[30] = umax_(a_, b_); }
  { const unsigned a_ = v[23], b_ = v[31]; v[23] = umin_(a_, b_); v[31] = umax_(a_, b_); }
  { const unsigned a_ = v[0], b_ = v[4]; v[0] = umax_(a_, b_); v[4] = umin_(a_, b_); }
  { const unsigned a_ = v[1], b_ = v[5]; v[1] = umax_(a_, b_); v[5] = umin_(a_, b_); }
  { const unsigned a_ = v[2], b_ = v[6]; v[2] = umax_(a_, b_); v[6] = umin_(a_, b_); }
  { const unsigned a_ = v[3], b_ = v[7]; v[3] = umax_(a_, b_); v[7] = umin_(a_, b_); }
  { const unsigned a_ = v[8], b_ = v[12]; v[8] = umax_(a_, b_); v[12] = umin_(a_, b_); }
  { const unsigned a_ = v[9], b_ = v[13]; v[9] = umax_(a_, b_); v[13] = umin_(a_, b_); }
  { const unsigned a_ = v[10], b_ = v[14]; v[10] = umax_(a_, b_); v[14] = umin_(a_, b_); }
  { const unsigned a_ = v[11], b_ = v[15]; v[11] = umax_(a_, b_); v[15] = umin_(a_, b_); }
  { const unsigned a_ = v[16], b_ = v[20]; v[16] = umin_(a_, b_); v[20] = umax_(a_, b_); }
  { const unsigned a_ = v[17], b_ = v[21]; v[17] = umin_(a_, b_); v[21] = umax_(a_, b_); }
  { const unsigned a_ = v[18], b_ = v[22]; v[18] = umin_(a_, b_); v[22] = umax_(a_, b_); }
  { const unsigned a_ = v[19], b_ = v[23]; v[19] = umin_(a_, b_); v[23] = umax_(a_, b_); }
  { const unsigned a_ = v[24], b_ = v[28]; v[24] = umin_(a_, b_); v[28] = umax_(a_, b_); }
  { const unsigned a_ = v[25], b_ = v[29]; v[25] = umin_(a_, b_); v[29] = umax_(a_, b_); }
  { const unsigned a_ = v[26], b_ = v[30]; v[26] = umin_(a_, b_); v[30] = umax_(a_, b_); }
  { const unsigned a_ = v[27], b_ = v[31]; v[27] = umin_(a_, b_); v[31] = umax_(a_, b_); }
  { const unsigned a_ = v[0], b_ = v[2]; v[0] = umax_(a_, b_); v[2] = umin_(a_, b_); }
  { const unsigned a_ = v[1], b_ = v[3]; v[1] = umax_(a_, b_); v[3] = umin_(a_, b_); }
  { const unsigned a_ = v[4], b_ = v[6]; v[4] = umax_(a_, b_); v[6] = umin_(a_, b_); }
  { const unsigned a_ = v[5], b_ = v[7]; v[5] = umax_(a_, b_); v[7] = umin_(a_, b_); }
  { const unsigned a_ = v[8], b_ = v[10]; v[8] = umax_(a_, b_); v[10] = umin_(a_, b_); }
  { const unsigned a_ = v[9], b_ = v[11]; v[9] = umax_(a_, b_); v[11] = umin_(a_, b_); }
  { const unsigned a_ = v[12], b_ = v[14]; v[12] = umax_(a_, b_); v[14] = umin_(a_, b_); }
  { const unsigned a_ = v[13], b_ = v[15]; v[13] = umax_(a_, b_); v[15] = umin_(a_, b_); }
  { const unsigned a_ = v[16], b_ = v[18]; v[16] = umin_(a_, b_); v[18] = umax_(a_, b_); }
  { const unsigned a_ = v[17], b_ = v[19]; v[17] = umin_(a_, b_); v[19] = umax_(a_, b_); }
  { const unsigned a_ = v[20], b_ = v[22]; v[20] = umin_(a_, b_); v[22] = umax_(a_, b_); }
  { const unsigned a_ = v[21], b_ = v[23]; v[21] = umin_(a_, b_); v[23] = umax_(a_, b_); }
  { const unsigned a_ = v[24], b_ = v[26]; v[24] = umin_(a_, b_); v[26] = umax_(a_, b_); }
  { const unsigned a_ = v[25], b_ = v[27]; v[25] = umin_(a_, b_); v[27] = umax_(a_, b_); }
  { const unsigned a_ = v[28], b_ = v[30]; v[28] = umin_(a_, b_); v[30] = umax_(a_, b_); }
  { const unsigned a_ = v[29], b_ = v[31]; v[29] = umin_(a_, b_); v[31] = umax_(a_, b_); }
  { const unsigned a_ = v[0], b_ = v[1]; v[0] = umax_(a_, b_); v[1] = umin_(a_, b_); }
  { const unsigned a_ = v[2], b_ = v[3]; v[2] = umax_(a_, b_); v[3] = umin_(a_, b_); }
  { const unsigned a_ = v[4], b_ = v[5]; v[4] = umax_(a_, b_); v[5] = umin_(a_, b_); }
  { const unsigned a_ = v[6], b_ = v[7]; v[6] = umax_(a_, b_); v[7] = umin_(a_, b_); }
  { const unsigned a_ = v[8], b_ = v[9]; v[8] = umax_(a_, b_); v[9] = umin_(a_, b_); }
  { const unsigned a_ = v[10], b_ = v[11]; v[10] = umax_(a_, b_); v[11] = umin_(a_, b_); }
  { const unsigned a_ = v[12], b_ = v[13]; v[12] = umax_(a_, b_); v[13] = umin_(a_, b_); }
  { const unsigned a_ = v[14], b_ = v[15]; v[14] = umax_(a_, b_); v[15] = umin_(a_, b_); }
  { const unsigned a_ = v[16], b_ = v[17]; v[16] = umin_(a_, b_); v[17] = umax_(a_, b_); }
  { const unsigned a_ = v[18], b_ = v[19]; v[18] = umin_(a_, b_); v[19] = umax_(a_, b_); }
  { const unsigned a_ = v[20], b_ = v[21]; v[20] = umin_(a_, b_); v[21] = umax_(a_, b_); }
  { const unsigned a_ = v[22], b_ = v[23]; v[22] = umin_(a_, b_); v[23] = umax_(a_, b_); }
  { const unsigned a_ = v[24], b_ = v[25]; v[24] = umin_(a_, b_); v[25] = umax_(a_, b_); }
  { const unsigned a_ = v[26], b_ = v[27]; v[26] = umin_(a_, b_); v[27] = umax_(a_, b_); }
  { const unsigned a_ = v[28], b_ = v[29]; v[28] = umin_(a_, b_); v[29] = umax_(a_, b_); }
  { const unsigned a_ = v[30], b_ = v[31]; v[30] = umin_(a_, b_); v[31] = umax_(a_, b_); }
  v[0] = umax_(v[0], v[16]);
  v[1] = umax_(v[1], v[17]);
  v[2] = umax_(v[2], v[18]);
  v[3] = umax_(v[3], v[19]);
  v[4] = umax_(v[4], v[20]);
  v[5] = umax_(v[5], v[21]);
  v[6] = umax_(v[6], v[22]);
  v[7] = umax_(v[7], v[23]);
  v[8] = umax_(v[8], v[24]);
  v[9] = umax_(v[9], v[25]);
  v[10] = umax_(v[10], v[26]);
  v[11] = umax_(v[11], v[27]);
  v[12] = umax_(v[12], v[28]);
  v[13] = umax_(v[13], v[29]);
  v[14] = umax_(v[14], v[30]);
  v[15] = umax_(v[15], v[31]);
  { const unsigned a_ = v[0], b_ = v[8]; v[0] = umax_(a_, b_); v[8] = umin_(a_, b_); }
  { const unsigned a_ = v[1], b_ = v[9]; v[1] = umax_(a_, b_); v[9] = umin_(a_, b_); }
  { const unsigned a_ = v[2], b_ = v[10]; v[2] = umax_(a_, b_); v[10] = umin_(a_, b_); }
  { const unsigned a_ = v[3], b_ = v[11]; v[3] = umax_(a_, b_); v[11] = umin_(a_, b_); }
  { const unsigned a_ = v[4], b_ = v[12]; v[4] = umax_(a_, b_); v[12] = umin_(a_, b_); }
  { const unsigned a_ = v[5], b_ = v[13]; v[5] = umax_(a_, b_); v[13] = umin_(a_, b_); }
  { const unsigned a_ = v[6], b_ = v[14]; v[6] = umax_(a_, b_); v[14] = umin_(a_, b_); }
  { const unsigned a_ = v[7], b_ = v[15]; v[7] = umax_(a_, b_); v[15] = umin_(a_, b_); }
  { const unsigned a_ = v[0], b_ = v[4]; v[0] = umax_(a_, b_); v[4] = umin_(a_, b_); }
  { const unsigned a_ = v[1], b_ = v[5]; v[1] = umax_(a_, b_); v[5] = umin_(a_, b_); }
  { const unsigned a_ = v[2], b_ = v[6]; v[2] = umax_(a_, b_); v[6] = umin_(a_, b_); }
  { const unsigned a_ = v[3], b_ = v[7]; v[3] = umax_(a_, b_); v[7] = umin_(a_, b_); }
  { const unsigned a_ = v[8], b_ = v[12]; v[8] = umax_(a_, b_); v[12] = umin_(a_, b_); }
  { const unsigned a_ = v[9], b_ = v[13]; v[9] = umax_(a_, b_); v[13] = umin_(a_, b_); }
  { const unsigned a_ = v[10], b_ = v[14]; v[10] = umax_(a_, b_); v[14] = umin_(a_, b_); }
  { const unsigned a_ = v[11], b_ = v[15]; v[11] = umax_(a_, b_); v[15] = umin_(a_, b_); }
  { const unsigned a_ = v[0], b_ = v[2]; v[0] = umax_(a_, b_); v[2] = umin_(a_, b_); }
  { const unsigned a_ = v[1], b_ = v[3]; v[1] = umax_(a_, b_); v[3] = umin_(a_, b_); }
  { const unsigned a_ = v[4], b_ = v[6]; v[4] = umax_(a_, b_); v[6] = umin_(a_, b_); }
  { const unsigned a_ = v[5], b_ = v[7]; v[5] = umax_(a_, b_); v[7] = umin_(a_, b_); }
  { const unsigned a_ = v[8], b_ = v[10]; v[8] = umax_(a_, b_); v[10] = umin_(a_, b_); }
  { const unsigned a_ = v[9], b_ = v[11]; v[9] = umax_(a_, b_); v[11] = umin_(a_, b_); }
  { const unsigned a_ = v[12], b_ = v[14]; v[12] = umax_(a_, b_); v[14] = umin_(a_, b_); }
  { const unsigned a_ = v[13], b_ = v[15]; v[13] = umax_(a_, b_); v[15] = umin_(a_, b_); }
  { const unsigned a_ = v[0], b_ = v[1]; v[0] = umax_(a_, b_); v[1] = umin_(a_, b_); }
  { const unsigned a_ = v[2], b_ = v[3]; v[2] = umax_(a_, b_); v[3] = umin_(a_, b_); }
  { const unsigned a_ = v[4], b_ = v[5]; v[4] = umax_(a_, b_); v[5] = umin_(a_, b_); }
  { const unsigned a_ = v[6], b_ = v[7]; v[6] = umax_(a_, b_); v[7] = umin_(a_, b_); }
  { const unsigned a_ = v[8], b_ = v[9]; v[8] = umax_(a_, b_); v[9] = umin_(a_, b_); }
  { const unsigned a_ = v[10], b_ = v[11]; v[10] = umax_(a_, b_); v[11] = umin_(a_, b_); }
  { const unsigned a_ = v[12], b_ = v[13]; v[12] = umax_(a_, b_); v[13] = umin_(a_, b_); }
  { const unsigned a_ = v[14], b_ = v[15]; v[14] = umax_(a_, b_); v[15] = umin_(a_, b_); }
}
DI void merge16(unsigned (&v)[32], int m) {
  unsigned o[16];
  o[0] = shx(v[15], m);
  o[1] = shx(v[14], m);
  o[2] = shx(v[13], m);
  o[3] = shx(v[12], m);
  o[4] = shx(v[11], m);
  o[5] = shx(v[10], m);
  o[6] = shx(v[9], m);
  o[7] = shx(v[8], m);
  o[8] = shx(v[7], m);
  o[9] = shx(v[6], m);
  o[10] = shx(v[5], m);
  o[11] = shx(v[4], m);
  o[12] = shx(v[3], m);
  o[13] = shx(v[2], m);
  o[14] = shx(v[1], m);
  o[15] = shx(v[0], m);
  v[0] = umax_(v[0], o[0]);
  v[1] = umax_(v[1], o[1]);
  v[2] = umax_(v[2], o[2]);
  v[3] = umax_(v[3], o[3]);
  v[4] = umax_(v[4], o[4]);
  v[5] = umax_(v[5], o[5]);
  v[6] = umax_(v[6], o[6]);
  v[7] = umax_(v[7], o[7]);
  v[8] = umax_(v[8], o[8]);
  v[9] = umax_(v[9], o[9]);
  v[10] = umax_(v[10], o[10]);
  v[11] = umax_(v[11], o[11]);
  v[12] = umax_(v[12], o[12]);
  v[13] = umax_(v[13], o[13]);
  v[14] = umax_(v[14], o[14]);
  v[15] = umax_(v[15], o[15]);
  { const unsigned a_ = v[0], b_ = v[8]; v[0] = umax_(a_, b_); v[8] = umin_(a_, b_); }
  { const unsigned a_ = v[1], b_ = v[9]; v[1] = umax_(a_, b_); v[9] = umin_(a_, b_); }
  { const unsigned a_ = v[2], b_ = v[10]; v[2] = umax_(a_, b_); v[10] = umin_(a_, b_); }
  { const unsigned a_ = v[3], b_ = v[11]; v[3] = umax_(a_, b_); v[11] = umin_(a_, b_); }
  { const unsigned a_ = v[4], b_ = v[12]; v[4] = umax_(a_, b_); v[12] = umin_(a_, b_); }
  { const unsigned a_ = v[5], b_ = v[13]; v[5] = umax_(a_, b_); v[13] = umin_(a_, b_); }
  { const unsigned a_ = v[6], b_ = v[14]; v[6] = umax_(a_, b_); v[14] = umin_(a_, b_); }
  { const unsigned a_ = v[7], b_ = v[15]; v[7] = umax_(a_, b_); v[15] = umin_(a_, b_); }
  { const unsigned a_ = v[0], b_ = v[4]; v[0] = umax_(a_, b_); v[4] = umin_(a_, b_); }
  { const unsigned a_ = v[1], b_ = v[5]; v[1] = umax_(a_, b_); v[5] = umin_(a_, b_); }
  { const unsigned a_ = v[2], b_ = v[6]; v[2] = umax_(a_, b_); v[6] = umin_(a_, b_); }
  { const unsigned a_ = v[3], b_ = v[7]; v[3] = umax_(a_, b_); v[7] = umin_(a_, b_); }
  { const unsigned a_ = v[8], b_ = v[12]; v[8] = umax_(a_, b_); v[12] = umin_(a_, b_); }
  { const unsigned a_ = v[9], b_ = v[13]; v[9] = umax_(a_, b_); v[13] = umin_(a_, b_); }
  { const unsigned a_ = v[10], b_ = v[14]; v[10] = umax_(a_, b_); v[14] = umin_(a_, b_); }
  { const unsigned a_ = v[11], b_ = v[15]; v[11] = umax_(a_, b_); v[15] = umin_(a_, b_); }
  { const unsigned a_ = v[0], b_ = v[2]; v[0] = umax_(a_, b_); v[2] = umin_(a_, b_); }
  { const unsigned a_ = v[1], b_ = v[3]; v[1] = umax_(a_, b_); v[3] = umin_(a_, b_); }
  { const unsigned a_ = v[4], b_ = v[6]; v[4] = umax_(a_, b_); v[6] = umin_(a_, b_); }
  { const unsigned a_ = v[5], b_ = v[7]; v[5] = umax_(a_, b_); v[7] = umin_(a_, b_); }
  { const unsigned a_ = v[8], b_ = v[10]; v[8] = umax_(a_, b_); v[10] = umin_(a_, b_); }
  { const unsigned a_ = v[9], b_ = v[11]; v[9] = umax_(a_, b_); v[11] = umin_(a_, b_); }
  { const unsigned a_ = v[12], b_ = v[14]; v[12] = umax_(a_, b_); v[14] = umin_(a_, b_); }
  { const unsigned a_ = v[13], b_ = v[15]; v[13] = umax_(a_, b_); v[15] = umin_(a_, b_); }
  { const unsigned a_ = v[0], b_ = v[1]; v[0] = umax_(a_, b_); v[1] = umin_(a_, b_); }
  { const unsigned a_ = v[2], b_ = v[3]; v[2] = umax_(a_, b_); v[3] = umin_(a_, b_); }
  { const unsigned a_ = v[4], b_ = v[5]; v[4] = umax_(a_, b_); v[5] = umin_(a_, b_); }
  { const unsigned a_ = v[6], b_ = v[7]; v[6] = umax_(a_, b_); v[7] = umin_(a_, b_); }
  { const unsigned a_ = v[8], b_ = v[9]; v[8] = umax_(a_, b_); v[9] = umin_(a_, b_); }
  { const unsigned a_ = v[10], b_ = v[11]; v[10] = umax_(a_, b_); v[11] = umin_(a_, b_); }
  { const unsigned a_ = v[12], b_ = v[13]; v[12] = umax_(a_, b_); v[13] = umin_(a_, b_); }
  { const unsigned a_ = v[14], b_ = v[15]; v[14] = umax_(a_, b_); v[15] = umin_(a_, b_); }
}

DI void phase_route(const Params& P, int l) {
  const int tid_ = otid(); const int lane = tid_ & 63, w = tid_ >> 6;
  const u16* PQ = (const u16*)(P.ws + OFF_PQ);
  const u16* KEYS = (const u16*)(P.ws + OFF_KEYS);
  int* EIDX = (int*)(P.ws + OFF_EIDX);
  float* EG = (float*)(P.ws + OFF_EG);
  const int n = lane & 15, g4 = lane >> 4;
  for (int item = blockIdx.x * 4 + w; item < 1024 * 8; item += gridDim.x * 4) {
    const int hh = item & 7, t0 = (item >> 3) * 16;
    const u16* pq = PQ + (size_t)(t0 + n) * 1024 + hh * 128;
    unsigned v[2][32];
#pragma unroll
    for (int p = 0; p < 2; ++p) {
      const bf16x8 q0 = *(const bf16x8*)(pq + p * 64 + 8 * g4);
      const bf16x8 q1 = *(const bf16x8*)(pq + p * 64 + 32 + 8 * g4);
      const u16* kb = KEYS + (size_t)(((l * 8 + hh) * 2 + p) * 128) * 64;
#pragma unroll
      for (int mt = 0; mt < 8; ++mt) {
        const bf16x8 a0 = *(const bf16x8*)(kb + (size_t)(mt * 16 + n) * 64 + 8 * g4);
        const bf16x8 a1 = *(const bf16x8*)(kb + (size_t)(mt * 16 + n) * 64 + 32 + 8 * g4);
        f32x4 d = {0.f, 0.f, 0.f, 0.f};
        d = MFMA16(a0, q0, d);
        d = MFMA16(a1, q1, d);
#pragma unroll
        for (int i = 0; i < 4; ++i) v[p][mt * 4 + i] = sortkey(d[i], 0x7Fu, (unsigned)(127 - (mt * 16 + 4 * g4 + i)));
      }
    }
    float s1v[16], s2v[16];
    int i1[16], i2[16];
#pragma unroll
    for (int p = 0; p < 2; ++p) {
      sort32_top16(v[p]);
      merge16(v[p], 16);
      merge16(v[p], 32);
    }
#pragma unroll
    for (int it = 0; it < 16; ++it) {
      s1v[it] = unsortkey(v[0][it], 0x7Fu);
      i1[it] = 127 - (int)(v[0][it] & 0x7Fu);
      s2v[it] = unsortkey(v[1][it], 0x7Fu);
      i2[it] = 127 - (int)(v[1][it] & 0x7Fu);
    }
    float sa[4];
    int ia[4];
#pragma unroll
    for (int q = 0; q < 4; ++q) {
      sa[q] = sel4f(g4, s1v[4 * q], s1v[4 * q + 1], s1v[4 * q + 2], s1v[4 * q + 3]);
      ia[q] = sel4i(g4, i1[4 * q], i1[4 * q + 1], i1[4 * q + 2], i1[4 * q + 3]);
    }
    unsigned cand[21];
    int ce[21];
#pragma unroll
    for (int bb = 0; bb < 16; ++bb) {
      const bool ok = (g4 + 1) * (bb + 1) <= 16;
      cand[bb] = ok ? sortkey(sa[0] + s2v[bb], 0xFFu, (unsigned)(255 - (g4 * 16 + bb))) : 0u;
      ce[bb] = ia[0] * 128 + i2[bb];
    }
#pragma unroll
    for (int bb = 0; bb < 3; ++bb) {
      const bool ok = (5 + g4) * (bb + 1) <= 16;
      cand[16 + bb] = ok ? sortkey(sa[1] + s2v[bb], 0xFFu, (unsigned)(255 - ((4 + g4) * 16 + bb))) : 0u;
      ce[16 + bb] = ia[1] * 128 + i2[bb];
    }
    cand[19] = sortkey(sa[2] + s2v[0], 0xFFu, (unsigned)(255 - ((8 + g4) * 16)));
    ce[19] = ia[2] * 128 + i2[0];
    cand[20] = sortkey(sa[3] + s2v[0], 0xFFu, (unsigned)(255 - ((12 + g4) * 16)));
    ce[20] = ia[3] * 128 + i2[0];
    float sv[16];
    int* eo = EIDX + (size_t)(t0 + n) * 128 + hh * 16;
#pragma unroll
    for (int it = 0; it < 16; ++it) {
      unsigned mx = 0u;
#pragma unroll
      for (int j = 0; j < 21; ++j) mx = umax_(mx, cand[j]);
      mx = umax_(mx, shx(mx, 16));
      mx = umax_(mx, shx(mx, 32));
      sv[it] = unsortkey(mx, 0xFFu);
      int e = -1;
#pragma unroll
      for (int j = 0; j < 21; ++j) {
        const bool eq = (cand[j] == mx);
        e = eq ? ce[j] : e;
        cand[j] = eq ? 0u : cand[j];
      }
      if (e >= 0) eo[it] = e;
    }
    const float top = sv[0];
    float den = 0.f;
#pragma unroll
    for (int it = 0; it < 16; ++it) { sv[it] = __expf(sv[it] - top); den += sv[it]; }
    const float rden = 1.f / den;
    if (g4 == 0) {
      float* go = EG + (size_t)(t0 + n) * 128 + hh * 16;
#pragma unroll
      for (int q = 0; q < 4; ++q)
        *(float4*)(go + 4 * q) = make_float4(sv[4 * q] * rden, sv[4 * q + 1] * rden, sv[4 * q + 2] * rden, sv[4 * q + 3] * rden);
    }
  }
}

template <int B> DI f32x2 unp4(unsigned w) { return __builtin_amdgcn_cvt_scalef32_pk_f32_fp4(w, 1.0f, B); }
DI void cvt16(const u32x4& a, float (&f)[16]) {
#pragma unroll
  for (int q = 0; q < 4; ++q) {
    const f32x2 lo = __builtin_amdgcn_cvt_pk_f32_fp8(a[q], false);
    const f32x2 hi = __builtin_amdgcn_cvt_pk_f32_fp8(a[q], true);
    f[4 * q] = lo.x; f[4 * q + 1] = lo.y; f[4 * q + 2] = hi.x; f[4 * q + 3] = hi.y;
  }
}

DI void phase_gather(const Params& P, int l) {
  const int tid_ = otid(); const int lane = tid_ & 63, w = tid_ >> 6;
  const u16* H = (const u16*)(P.ws + OFF_H);
  const int* EIDX = (const int*)(P.ws + OFF_EIDX);
  const float* EG = (const float*)(P.ws + OFF_EG);
  const unsigned char* U = (const unsigned char*)(P.ws + OFF_U) + (size_t)l * 16384 * 512;
  const unsigned char* V = (const unsigned char*)(P.ws + OFF_V) + (size_t)l * 16384 * 512;
  const float* USC = (const float*)(P.ws + OFF_USC) + (size_t)l * 16384;
  const float* VSC = (const float*)(P.ws + OFF_VSC) + (size_t)l * 16384;
  const float* MODS = (const float*)(P.ws + OFF_MODS);
  float* X = (float*)(P.ws + OFF_X);
  u16* Hn = (u16*)(P.ws + OFF_H);
  for (int t = blockIdx.x * 4 + w; t < T; t += gridDim.x * 4) {
    float acc[16];
#pragma unroll
    for (int i = 0; i < 16; ++i) acc[i] = 0.f;
#if DO_PEER
    f32x2 hf2[8];
    {
      const u32x4 h0 = *(const u32x4*)(H + (size_t)t * 1024 + lane * 16);
      const u32x4 h1 = *(const u32x4*)(H + (size_t)t * 1024 + lane * 16 + 8);
#pragma unroll
      for (int q = 0; q < 4; ++q) {
        hf2[q] = (f32x2){bflo(h0[q]), bfhi(h0[q])};
        hf2[4 + q] = (f32x2){bflo(h1[q]), bfhi(h1[q])};
      }
    }
    const int e0 = EIDX[(size_t)t * 128 + lane], e1 = EIDX[(size_t)t * 128 + 64 + lane];
    const float g0 = EG[(size_t)t * 128 + lane] * VSC[e0], g1 = EG[(size_t)t * 128 + 64 + lane] * VSC[e1];
    const float su0 = USC[e0], su1 = USC[e1];
    float w0 = 0.f, w1 = 0.f;
    f32x2 acc2[8];
#pragma unroll 1
    for (int rep = 0; rep < REP_GATHER; ++rep) {
#pragma unroll
    for (int i = 0; i < 8; ++i) acc2[i] = (f32x2){0.f, 0.f};
    u32x2 bufA[32], bufB[32];
#define G_LOAD(BUF, TAB, C)                                                                   \
  _Pragma("unroll") for (int j = 0; j < 32; ++j) {                                            \
    const int idx_ = __builtin_amdgcn_readlane(((C) < 2) ? e0 : e1, (((C) & 1) << 5) + j);    \
    BUF[j] = *(const u32x2*)(TAB + (size_t)idx_ * 512 + lane * 8);                            \
  }
#define G_UCOMP(BUF, C)                                                                       \
  {                                                                                           \
    float p[32];                                                                              \
    _Pragma("unroll") for (int j = 0; j < 32; ++j) {                                          \
      f32x2 a2 = {0.f, 0.f};                                                                  \
      _Pragma("unroll") for (int d = 0; d < 2; ++d) {                                         \
        a2 = __builtin_elementwise_fma(unp4<0>(BUF[j][d]), hf2[4 * d + 0], a2);               \
        a2 = __builtin_elementwise_fma(unp4<1>(BUF[j][d]), hf2[4 * d + 1], a2);               \
        a2 = __builtin_elementwise_fma(unp4<2>(BUF[j][d]), hf2[4 * d + 2], a2);               \
        a2 = __builtin_elementwise_fma(unp4<3>(BUF[j][d]), hf2[4 * d + 3], a2);               \
      }                                                                                       \
      p[j] = a2.x + a2.y;                                                                     \
    }                                                                                         \
    float q1 = xsum32(p, lane);                                                               \
    q1 += __shfl_xor(q1, 32);                                                                 \
    const bool mine = (lane >> 5) == ((C) & 1);                                               \
    if ((C) < 2) w0 = mine ? gelu_tanh(q1 * su0) * g0 : w0;                                   \
    else w1 = mine ? gelu_tanh(q1 * su1) * g1 : w1;                                           \
  }
#define G_VCOMP(BUF, C)                                                                       \
  {                                                                                           \
    const float wv_ = ((C) < 2) ? w0 : w1;                                                    \
    _Pragma("unroll") for (int j = 0; j < 32; ++j) {                                          \
      const float wj = __int_as_float(__builtin_amdgcn_readlane(__float_as_int(wv_), (((C) & 1) << 5) + j)); \
      const f32x2 wv2 = {wj, wj};                                                             \
      _Pragma("unroll") for (int d = 0; d < 2; ++d) {                                         \
        acc2[4 * d + 0] = __builtin_elementwise_fma(wv2, unp4<0>(BUF[j][d]), acc2[4 * d + 0]); \
        acc2[4 * d + 1] = __builtin_elementwise_fma(wv2, unp4<1>(BUF[j][d]), acc2[4 * d + 1]); \
        acc2[4 * d + 2] = __builtin_elementwise_fma(wv2, unp4<2>(BUF[j][d]), acc2[4 * d + 2]); \
        acc2[4 * d + 3] = __builtin_elementwise_fma(wv2, unp4<3>(BUF[j][d]), acc2[4 * d + 3]); \
      }                                                                                       \
    }                                                                                         \
  }
#define G_SB __builtin_amdgcn_sched_barrier(0);
    G_LOAD(bufA, U, 0) G_SB
    G_LOAD(bufB, U, 1) G_SB  G_UCOMP(bufA, 0) G_SB
    G_LOAD(bufA, U, 2) G_SB  G_UCOMP(bufB, 1) G_SB
    G_LOAD(bufB, U, 3) G_SB  G_UCOMP(bufA, 2) G_SB
    G_LOAD(bufA, V, 0) G_SB  G_UCOMP(bufB, 3) G_SB
    G_LOAD(bufB, V, 1) G_SB  G_VCOMP(bufA, 0) G_SB
    G_LOAD(bufA, V, 2) G_SB  G_VCOMP(bufB, 1) G_SB
    G_LOAD(bufB, V, 3) G_SB  G_VCOMP(bufA, 2) G_SB
    G_VCOMP(bufB, 3)
#undef G_LOAD
#undef G_UCOMP
#undef G_VCOMP
#undef G_SB
    asm volatile("" : "+v"(w0), "+v"(w1));
    }
#pragma unroll
    for (int i = 0; i < 8; ++i) { acc[2 * i] = acc2[i].x; acc[2 * i + 1] = acc2[i].y; }
#endif
    const int b = t >> 12;
    const float* md = MODS + (size_t)(l * 4 + b) * 6144;
    float v[16];
#pragma unroll
    for (int half = 0; half < 2; ++half) {
      const int d0 = lane * 16 + half * 8;
      const float4 xa = *(const float4*)(X + (size_t)t * 1024 + d0), xb = *(const float4*)(X + (size_t)t * 1024 + d0 + 4);
      const float xv[8] = {xa.x, xa.y, xa.z, xa.w, xb.x, xb.y, xb.z, xb.w};
#pragma unroll
      for (int i = 0; i < 8; ++i) v[half * 8 + i] = DN_ALPHA * xv[i] + md[5120 + d0 + i] * acc[half * 8 + i];
    }
    const float* gam = P.ln_g + (size_t)(l * 2 + 1) * 1024;
    const float* bet = P.ln_b + (size_t)(l * 2 + 1) * 1024;
    if (l == NL - 1) {
      ln_finish<1>(v, (size_t)t, lane, gam, bet, nullptr, nullptr, P.out, nullptr);
    } else {
      const float* mdn = MODS + (size_t)((l + 1) * 4 + b) * 6144;
      ln_finish<1>(v, (size_t)t, lane, gam, bet, mdn, mdn + 1024, X, Hn);
    }
  }
}

#define XB_TMO      128
#define XB_XCNT(j)  (256  + 64 * (j))
#define XB_XSUB(j)  (1280 + 64 * (j))
#define XB_XGEN(j)  (2304 + 64 * (j))
#define XB_TOP      3328
#define XB_TOPGEN   3392
#define XCD_BAR_WORDS 3456
#define XB_SPIN_CAP (1u << 18)
#define LAS __attribute__((address_space(3)))

__device__ __forceinline__ unsigned xb_ld(unsigned* p)              { return __hip_atomic_load(p, __ATOMIC_RELAXED, __HIP_MEMORY_SCOPE_AGENT); }
__device__ __forceinline__ unsigned xb_add(unsigned* p, unsigned v) { return __hip_atomic_fetch_add(p, v, __ATOMIC_RELAXED, __HIP_MEMORY_SCOPE_AGENT); }
__device__ __forceinline__ unsigned xb_xcc_id() { return (unsigned)__builtin_amdgcn_s_getreg((3 << 11) | 20) & 0xFu; }
#define XB_SPIN(cond, bar) do { unsigned _sp = 0; while (cond) { __builtin_amdgcn_s_sleep(1); \
    if ((++_sp & 255u) == 0u) { if (xb_ld(&(bar)[XB_TMO])) break; if (_sp > XB_SPIN_CAP) { atomicAdd(&(bar)[XB_TMO], 1u); break; } } } } while (0)

struct XcdBarrier {
    unsigned* bar; unsigned x;
    volatile LAS unsigned* st;
};

__device__ __forceinline__ XcdBarrier xcd_barrier_post(unsigned* bar, volatile LAS unsigned* st) {
    XcdBarrier b; b.bar = bar; b.x = xb_xcc_id(); b.st = st;
    if (threadIdx.x == 0) (void)xb_add(&bar[XB_XCNT(b.x)], 1u);
    return b;
}
__device__ __forceinline__ void xcd_barrier_complete(unsigned* bar, unsigned x, unsigned& nloc, unsigned& nx) {
    const unsigned G = gridDim.x * gridDim.y * gridDim.z;
    unsigned sum, cnt, mine, sp = 0u;
    for (;;) {
        sum = 0u; cnt = 0u; mine = 0u;
#pragma unroll
        for (unsigned j = 0; j < 16; ++j) { const unsigned c = xb_ld(&bar[XB_XCNT(j)]); sum += c; cnt += (c > 0u) ? 1u : 0u; mine = (j == x) ? c : mine; }
        if (sum == G) break;
        __builtin_amdgcn_s_sleep(1);
        if ((++sp & 255u) == 0u) { if (xb_ld(&bar[XB_TMO])) break; if (sp > XB_SPIN_CAP) { atomicAdd(&bar[XB_TMO], 1u); break; } }
    }
    nloc = mine > 0u ? mine : 1u; nx = cnt > 0u ? cnt : 1u;
}

__device__ __forceinline__ void xcd_barrier(const XcdBarrier& b) {
    asm volatile("s_waitcnt vmcnt(0)" ::: "memory");
    __syncthreads();
    if (threadIdx.x == 0) {
        unsigned* bar = b.bar;
        __builtin_amdgcn_s_waitcnt(0);
        unsigned nloc = b.st[0], nx = b.st[1];
        if (nloc == 0u) { xcd_barrier_complete(bar, b.x, nloc, nx); b.st[0] = nloc; b.st[1] = nx; }
        const unsigned old = xb_add(&bar[XB_XSUB(b.x)], 1u);
        const unsigned gen = old / nloc;
        if (old + 1u == (gen + 1u) * nloc) {
            __builtin_amdgcn_fence(__ATOMIC_RELEASE, "agent");
            asm volatile("s_waitcnt vmcnt(0)" ::: "memory");
            const unsigned og = xb_add(&bar[XB_TOP], 1u);
            const unsigned tg = og / nx;
            if (og + 1u == (tg + 1u) * nx) xb_add(&bar[XB_TOPGEN], 1u);
            else XB_SPIN(xb_ld(&bar[XB_TOPGEN]) == tg, bar);
            __builtin_amdgcn_fence(__ATOMIC_ACQUIRE, "agent");
            xb_add(&bar[XB_XGEN(b.x)], 1u);
            asm volatile("s_waitcnt vmcnt(0)" ::: "memory");
        } else {
            XB_SPIN(xb_ld(&bar[XB_XGEN(b.x)]) == gen, bar);
            __builtin_amdgcn_fence(__ATOMIC_ACQUIRE, "agent");
            asm volatile("s_waitcnt vmcnt(0)" ::: "memory");
        }
    }
    __syncthreads();
}

__global__ void __launch_bounds__(256, 2) mega(Params P) {
  cg::grid_group grid = cg::this_grid();
  __shared__ __attribute__((aligned(16))) char smraw[73728];
  __shared__ uint4 xb_words;
  if (threadIdx.x == 0) xb_words = make_uint4(0u, 0u, 0u, 0u);
  __syncthreads();
  (void)xcd_barrier_post((unsigned*)(P.ws + OFF_BAR), (volatile LAS unsigned*)&xb_words);
#define XBAR() { XcdBarrier b_; b_.bar = (unsigned*)(P.ws + OFF_BAR); b_.x = xb_xcc_id(); b_.st = (volatile LAS unsigned*)&xb_words; xcd_barrier(b_); }
  phase0a(P, smraw);
  grid.sync();
  phase0b(P);
  XBAR()
  for (int l = 0; l < NL; ++l) {
#if DO_MIXER
#if PHM & 1
    for (int rep = 0; rep < REP_G1; ++rep) phase_gemm1(P, l, smraw);
#endif
    XBAR()
#if PHM & 2
    for (int rep = 0; rep < REP_CP; ++rep) phase_cmp_pool(P, l, smraw);
#endif
    XBAR()
#if PHM & 4
    for (int rep = 0; rep < REP_ATT; ++rep) phase_attn(P, l, smraw);
#endif
    XBAR()
#if PHM & 8
    phase_gemm2(P, l, smraw);
#endif
    XBAR()
#endif
    phase_gemm3(P, l, smraw);
    XBAR()
#if DO_PEER
#if PHM & 16
    phase_gemm4(P, l, smraw);
#endif
    XBAR()
#if PHM & 32
    for (int rep = 0; rep < REP_ROUTE; ++rep) phase_route(P, l);
#endif
    XBAR()
#endif
    phase_gather(P, l);
    XBAR()
  }
}

extern "C" void kernel_launch(void* const* d_in, const int* in_sizes, int n_in, void* d_out, int out_size, void* d_ws,
                              size_t ws_size, hipStream_t stream) {
  static int grid_blocks = 0;
  if (!grid_blocks) {
    int dev = 0, cus = 0, per_cu = 0;
    hipGetDevice(&dev);
    hipDeviceGetAttribute(&cus, hipDeviceAttributeMultiprocessorCount, dev);
    hipOccupancyMaxActiveBlocksPerMultiprocessor(&per_cu, mega, 256, 0);
    if (per_cu > 2) per_cu = 2;
    grid_blocks = cus * per_cu;
    if (per_cu < 2 || cus != 256) { fprintf(stderr, "unexpected occupancy %d x %d\n", cus, per_cu); grid_blocks = -1; }
  }
  if (grid_blocks <= 0) return;
  if (ws_size < WS_END) { fprintf(stderr, "workspace too small: %zu < %zu\n", ws_size, (size_t)WS_END); return; }
  Params p{};
  p.x = (const float*)d_in[0]; p.c = (const float*)d_in[1]; p.w_ada = (const float*)d_in[2]; p.b_ada = (const float*)d_in[3];
  p.w_in = (const float*)d_in[4]; p.cmp_pe = (const float*)d_in[5]; p.cmp_w1 = (const float*)d_in[6];
  p.cmp_w2 = (const float*)d_in[7]; p.w_pool = (const float*)d_in[8]; p.pool_scale = (const float*)d_in[9];
  p.w_lift = (const float*)d_in[10]; p.w_o = (const float*)d_in[11]; p.ln_g = (const float*)d_in[12];
  p.ln_b = (const float*)d_in[13]; p.peer_wq = (const float*)d_in[14]; p.peer_keys = (const float*)d_in[15];
  p.peer_u = (const float*)d_in[16]; p.peer_v = (const float*)d_in[17];
  p.out = (float*)d_out; p.ws = (char*)d_ws;
  hipMemsetAsync((char*)d_ws + OFF_BAR, 0, 16384, stream);
  void* args[] = {&p};
  hipError_t e = hipLaunchCooperativeKernel((void*)mega, dim3(grid_blocks), dim3(256), args, 0, stream);
  if (e != hipSuccess) fprintf(stderr, "cooperative launch failed: %s (grid %d)\n", hipGetErrorString(e), grid_blocks);
}
```

```cpp
#include <hip/hip_runtime.h>
#include <hip/hip_cooperative_groups.h>
#include <stdint.h>
#include <cstdio>
namespace cg = cooperative_groups;

typedef unsigned short u16;
typedef __attribute__((ext_vector_type(8))) short bf16x8;
typedef __attribute__((ext_vector_type(4))) short s16x4;
typedef __attribute__((ext_vector_type(16))) float f32x16;
typedef __attribute__((ext_vector_type(4))) float f32x4;
typedef __attribute__((ext_vector_type(2))) float f32x2;
typedef __attribute__((ext_vector_type(4))) unsigned u32x4;
typedef __attribute__((ext_vector_type(2))) unsigned u32x2;
typedef __attribute__((ext_vector_type(2))) __bf16 bf16x2v;

#define DI __device__ __forceinline__
#define MFMA32(a, b, c) __builtin_amdgcn_mfma_f32_32x32x16_bf16((a), (b), (c), 0, 0, 0)
#define MFMA16(a, b, c) __builtin_amdgcn_mfma_f32_16x16x32_bf16((a), (b), (c), 0, 0, 0)

#ifndef DO_MIXER
#define DO_MIXER 1
#endif
#ifndef PHM
#define PHM 255
#endif
#ifndef REP_G1
#define REP_G1 1
#endif
#ifndef REP_ATT
#define REP_ATT 1
#endif
#ifndef REP_ROUTE
#define REP_ROUTE 1
#endif
#ifndef REP_GATHER
#define REP_GATHER 1
#endif
#ifndef REP_CP
#define REP_CP 1
#endif
#ifndef DO_PEER
#define DO_PEER 1
#endif

constexpr int T = 16384, S = 4096, NL = 4;
constexpr int NPAD = 4096;
constexpr float L2E = 1.4426950408889634f;
constexpr float DN_ALPHA = 1.681792830507429f;

constexpr size_t OFF_X = 0;
constexpr size_t OFF_R = OFF_X + (size_t)T * 1024 * 4;
constexpr size_t OFF_H = OFF_R + (size_t)T * 1024 * 4;
constexpr size_t OFF_Q = OFF_H + (size_t)T * 1024 * 2;
constexpr size_t OFF_KV0 = OFF_Q + (size_t)T * 512 * 2;
constexpr size_t OFF_K12 = OFF_KV0 + (size_t)T * 256 * 2;
constexpr size_t OFF_VT = OFF_K12 + (size_t)T * 256 * 2;
constexpr size_t OFF_GATE = OFF_VT + (size_t)T * 256 * 2;
constexpr size_t OFF_PIN = OFF_GATE + (size_t)T * 24 * 4;
constexpr size_t OFF_GM = OFF_PIN + (size_t)T * 512 * 2;
constexpr size_t OFF_KC = OFF_GM + (size_t)T * 2048 * 2;
constexpr size_t OFF_VCT = OFF_KC + (size_t)4 * 2 * 256 * 64 * 2;
constexpr size_t OFF_OPOOL = OFF_VCT + (size_t)4 * 2 * 256 * 64 * 2;
constexpr size_t OFF_OATT = OFF_OPOOL + (size_t)T * 512 * 2;
constexpr size_t OFF_OACC = OFF_OATT + (size_t)T * 512 * 2;
constexpr size_t OFF_MERGED = OFF_OACC + (size_t)T * 512 * 4;
constexpr size_t OFF_PQ = OFF_MERGED + (size_t)T * 1024 * 2;
constexpr size_t OFF_EIDX = OFF_PQ + (size_t)T * 1024 * 2;
constexpr size_t OFF_EG = OFF_EIDX + (size_t)T * 128 * 4;
constexpr size_t OFF_MODS = OFF_EG + (size_t)T * 128 * 4;
constexpr size_t OFF_ROPE = OFF_MODS + (size_t)NL * 4 * 6144 * 4;
constexpr size_t OFF_CBIAS = OFF_ROPE + (size_t)4096 * 16 * 4;
constexpr size_t OFF_WIN = OFF_CBIAS + 16384;
constexpr size_t OFF_LIFT = OFF_WIN + (size_t)NL * NPAD * 1024 * 2;
constexpr size_t OFF_WO = OFF_LIFT + (size_t)NL * 2 * 1024 * 512 * 2;
constexpr size_t OFF_WQ = OFF_WO + (size_t)NL * 1024 * 1024 * 2;
constexpr size_t OFF_W1T = OFF_WQ + (size_t)NL * 1024 * 1024 * 2;
constexpr size_t OFF_W2T = OFF_W1T + (size_t)NL * 2 * 64 * 2048 * 2;
constexpr size_t OFF_WPT = OFF_W2T + (size_t)NL * 2 * 64 * 64 * 2;
constexpr size_t OFF_KEYS = OFF_WPT + (size_t)NL * 4 * 128 * 128 * 2;
constexpr size_t OFF_U = OFF_KEYS + (size_t)NL * 8 * 2 * 128 * 64 * 2;
constexpr size_t OFF_V = OFF_U + (size_t)NL * 16384 * 1024;
constexpr size_t OFF_USC = OFF_V + (size_t)NL * 16384 * 1024;
constexpr size_t OFF_VSC = OFF_USC + (size_t)NL * 16384 * 4;
constexpr size_t OFF_STATS = OFF_VSC + (size_t)NL * 16384 * 4;
constexpr size_t OFF_BAR = OFF_STATS + (size_t)T * 2 * 4;
constexpr int MT_CNT_WORD = 3600;
constexpr size_t WS_END = OFF_BAR + 16384;

struct Params {
  const float *x, *c, *w_ada, *b_ada, *w_in, *cmp_pe, *cmp_w1, *cmp_w2, *w_pool, *pool_scale, *w_lift, *w_o, *ln_g,
      *ln_b, *peer_wq, *peer_keys, *peer_u, *peer_v;
  float* out;
  char* ws;
};

DI int otid() { int t = threadIdx.x; asm volatile("" : "+v"(t)); return t; }
DI int crow(int e, int h) { return (e & 3) + 8 * (e >> 2) + 4 * h; }
DI unsigned pk2(float a, float b) {
  f32x2 f = {a, b};
  bf16x2v r = __builtin_convertvector(f, bf16x2v);
  return __builtin_bit_cast(unsigned, r);
}
DI u16 f2bf(float a) { return (u16)(pk2(a, 0.f) & 0xffffu); }
DI float bflo(unsigned u) { return __uint_as_float(u << 16); }
DI float bfhi(unsigned u) { return __uint_as_float(u & 0xffff0000u); }
DI float bf2f(u16 v) { return __uint_as_float(((unsigned)v) << 16); }
DI float ex2(float x) { return __builtin_amdgcn_exp2f(x); }
DI float sigmoidf_(float x) { return 1.f / (1.f + __expf(-x)); }
DI float gelu_tanh(float x) {
  float u = 0.7978845608028654f * (x + 0.044715f * x * x * x);
  float e = __expf(2.f * u);
  float th = 1.f - 2.f / (e + 1.f);
  return 0.5f * x * (1.f + th);
}
DI f32x16 zero16() {
  f32x16 z;
#pragma unroll
  for (int i = 0; i < 16; ++i) z[i] = 0.f;
  return z;
}
DI float wsum(float v) {
#pragma unroll
  for (int o = 32; o > 0; o >>= 1) v += __shfl_xor(v, o);
  return v;
}
DI unsigned umax_(unsigned a, unsigned b) { return a > b ? a : b; }
DI unsigned shx(unsigned v, int m) { return (unsigned)__shfl_xor((int)v, m); }

constexpr int G_LS = 40;
constexpr int G_STG = (128 + 256) * G_LS;
DI void gemm_main(const u16* A, int lda, const u16* B, int ldb, int K, int m0, int n0, f32x16 (&acc)[2][4], u16* sm) {
  const int tid = otid(), lane = tid & 63, w = tid >> 6, wm = w >> 1, wn = w & 1, r = lane & 31, h = lane >> 5;
  const int lrow = tid >> 2, lk = (tid & 3) * 8;
  const unsigned voa = (unsigned)(lrow * lda + lk) * 2u;
  const unsigned vob = (unsigned)((4 * (lrow & 31) + (lrow >> 5)) * ldb + lk) * 2u;
  const char* Ab0 = (const char*)(A + (size_t)m0 * lda);
  const char* Bb0 = (const char*)(B + (size_t)n0 * ldb);
  const size_t sa = (size_t)64 * lda * 2, sb = (size_t)64 * ldb * 2;
  u32x4 ra0[2], rb0[4], ra1[2], rb1[4];
#define GLOAD(RA, RB, K0)                                                                               \
  {                                                                                                     \
    _Pragma("unroll") for (int i = 0; i < 2; ++i) RA[i] = *(const u32x4*)(Ab0 + i * sa + (size_t)(K0) * 2 + voa); \
    _Pragma("unroll") for (int i = 0; i < 4; ++i) RB[i] = *(const u32x4*)(Bb0 + (size_t)((i >> 1) * 128 + (i & 1) * 2) * ldb * 2 + (size_t)(K0) * 2 + vob); \
  }
#define SSTORE(RA, RB, ST)                                                                                      \
  {                                                                                                             \
    _Pragma("unroll") for (int i = 0; i < 2; ++i) *(u32x4*)(sm + (ST) * G_STG + (lrow + 64 * i) * G_LS + lk) = RA[i]; \
    _Pragma("unroll") for (int i = 0; i < 4; ++i) *(u32x4*)(sm + (ST) * G_STG + (128 + lrow + 64 * i) * G_LS + lk) = RB[i]; \
  }
#define COMPUTE(ST)                                                                                   \
  {                                                                                                   \
    const u16* Ab = sm + (ST) * G_STG + (wm * 64 + r) * G_LS + 8 * h;                                 \
    const u16* Bb = sm + (ST) * G_STG + (128 + wn * 128 + r) * G_LS + 8 * h;                          \
    bf16x8 af[2][2];                                                                                  \
    _Pragma("unroll") for (int ks = 0; ks < 2; ++ks) {                                                \
      af[ks][0] = *(const bf16x8*)(Ab + 16 * ks);                                                     \
      af[ks][1] = *(const bf16x8*)(Ab + 32 * G_LS + 16 * ks);                                         \
    }                                                                                                 \
    bf16x8 b0 = *(const bf16x8*)(Bb), b1 = *(const bf16x8*)(Bb + 16);                                 \
    _Pragma("unroll") for (int j = 0; j < 4; ++j) {                                                   \
      bf16x8 nb0 = b0, nb1 = b1;                                                                      \
      if (j < 3) { nb0 = *(const bf16x8*)(Bb + 32 * (j + 1) * G_LS); nb1 = *(const bf16x8*)(Bb + 32 * (j + 1) * G_LS + 16); } \
      acc[0][j] = MFMA32(af[0][0], b0, acc[0][j]);                                                    \
      acc[1][j] = MFMA32(af[0][1], b0, acc[1][j]);                                                    \
      acc[0][j] = MFMA32(af[1][0], b1, acc[0][j]);                                                    \
      acc[1][j] = MFMA32(af[1][1], b1, acc[1][j]);                                                    \
      b0 = nb0; b1 = nb1;                                                                             \
      __builtin_amdgcn_sched_barrier(0);                                                              \
    }                                                                                                 \
  }
  GLOAD(ra0, rb0, 0)
  GLOAD(ra1, rb1, 32)
  __syncthreads();
  SSTORE(ra0, rb0, 0)
  __syncthreads();
  const int nk = K >> 5;
  for (int kt = 0; kt < nk; kt += 2) {
    { const int k2 = (kt + 2 < nk) ? (kt + 2) * 32 : (K - 64); GLOAD(ra0, rb0, k2) }
    __builtin_amdgcn_sched_barrier(0);
    COMPUTE(0)
    SSTORE(ra1, rb1, 1)
    __syncthreads();
    { const int k3 = (kt + 3 < nk) ? (kt + 3) * 32 : (K - 32); GLOAD(ra1, rb1, k3) }
    __builtin_amdgcn_sched_barrier(0);
    COMPUTE(1)
    SSTORE(ra0, rb0, 0)
    __syncthreads();
  }
#undef GLOAD
#undef SSTORE
#undef COMPUTE
}

DI void gemm_tile(int q, int NT, int& mt, int& nt) {
  const int x = blockIdx.x & 7;
  const int PN = NT < 8 ? NT : 8, PM = 64 / PN, NG = NT / PN;
  const int p = q >> 6, mi = q % PM, ni = (q / PM) % PN;
  const int ng = p % NG, mh = p / NG;
  mt = 16 * x + PM * mh + mi;
  nt = PN * ng + ni;
}
#define GEMM_TILE_LOOP(NT) for (int q = blockIdx.x >> 3; q < 16 * (NT); q += gridDim.x >> 3)
#define ACC_ZERO(acc)                                   \
  _Pragma("unroll") for (int i = 0; i < 2; ++i)         \
  _Pragma("unroll") for (int j = 0; j < 4; ++j) acc[i][j] = zero16();

DI int win_colmap(int n) {
  if (n < 1280) return n;
  if (n < 1792) return 1304 + (n - 1280);
  if (n < 3840) return 1816 + (n - 1792);
  if (n < 3864) return 1280 + (n - 3840);
  return -1;
}

DI void tr_family(const float* src, size_t src_mat, int ldsrc, u16* dst, size_t dst_mat, int K, int Ndst, int nmat,
                  int mode, float* sm) {
  const int tid = otid();
  const int tk = K >> 6, tn = Ndst >> 6;
  const int per = tk * tn;
  for (int it = blockIdx.x; it < per * nmat; it += gridDim.x) {
    const int mat = it / per, rem = it % per;
    const int k0 = (rem / tn) * 64, n0 = (rem % tn) * 64;
    const float* s = src + (size_t)mat * src_mat;
    u16* d = dst + (size_t)mat * dst_mat;
    const int tx = tid & 63, ty = tid >> 6;
    const int nd = n0 + tx;
    const int ns = (mode == 1) ? win_colmap(nd) : nd;
    __syncthreads();
    float tv[16];
#pragma unroll
    for (int i = 0; i < 16; ++i) tv[i] = (ns >= 0) ? s[(size_t)(k0 + ty + 4 * i) * ldsrc + ns] : 0.f;
#pragma unroll
    for (int i = 0; i < 16; ++i) sm[(ty + 4 * i) * 65 + tx] = tv[i];
    __syncthreads();
    const int nr = tid >> 2, kseg = (tid & 3) * 16;
    unsigned pkd[8];
#pragma unroll
    for (int j = 0; j < 8; ++j) pkd[j] = pk2(sm[(kseg + 2 * j) * 65 + nr], sm[(kseg + 2 * j + 1) * 65 + nr]);
    uint4* dp = (uint4*)(d + (size_t)(n0 + nr) * K + k0 + kseg);
    dp[0] = make_uint4(pkd[0], pkd[1], pkd[2], pkd[3]);
    dp[1] = make_uint4(pkd[4], pkd[5], pkd[6], pkd[7]);
  }
}

DI void conv_plain(const float* src, u16* dst, size_t n) {
  const size_t gt = (size_t)blockIdx.x * 256 + otid(), gs = (size_t)gridDim.x * 256;
  for (size_t i = gt; i < n / 8; i += gs) {
    const float4 a = ((const float4*)src)[2 * i], b = ((const float4*)src)[2 * i + 1];
    ((uint4*)dst)[i] = make_uint4(pk2(a.x, a.y), pk2(a.z, a.w), pk2(b.x, b.y), pk2(b.z, b.w));
  }
}

DI void conv_fp8_rows(const float* src, unsigned char* dst, float* inv_scale, int nrows) {
  const int tid = otid(), lane = tid & 63, w = tid >> 6;
  for (int row0 = (blockIdx.x * 4 + w) * 4; row0 < nrows; row0 += gridDim.x * 16) {
    f32x4 v[4][4];
#pragma unroll
    for (int rr = 0; rr < 4; ++rr) {
      const f32x4* sp = (const f32x4*)(src + (size_t)(row0 + rr) * 1024 + lane * 16);
#pragma unroll
      for (int q = 0; q < 4; ++q) v[rr][q] = __builtin_nontemporal_load(sp + q);
    }
#pragma unroll
    for (int rr = 0; rr < 4; ++rr) {
      float am = 0.f;
#pragma unroll
      for (int q = 0; q < 4; ++q)
        am = fmaxf(am, fmaxf(fmaxf(fabsf(v[rr][q].x), fabsf(v[rr][q].y)), fmaxf(fabsf(v[rr][q].z), fabsf(v[rr][q].w))));
#pragma unroll
      for (int o = 32; o > 0; o >>= 1) am = fmaxf(am, __shfl_xor(am, o));
      const float sc = (am > 0.f) ? (6.f / am) : 1.f;
      u32x2 out;
#pragma unroll
      for (int d = 0; d < 2; ++d) {
        unsigned wd = 0u;
        wd = __builtin_amdgcn_cvt_scalef32_pk_fp4_f32(wd, v[rr][2 * d].x * sc, v[rr][2 * d].y * sc, 1.0f, 0);
        wd = __builtin_amdgcn_cvt_scalef32_pk_fp4_f32(wd, v[rr][2 * d].z * sc, v[rr][2 * d].w * sc, 1.0f, 1);
        wd = __builtin_amdgcn_cvt_scalef32_pk_fp4_f32(wd, v[rr][2 * d + 1].x * sc, v[rr][2 * d + 1].y * sc, 1.0f, 2);
        wd = __builtin_amdgcn_cvt_scalef32_pk_fp4_f32(wd, v[rr][2 * d + 1].z * sc, v[rr][2 * d + 1].w * sc, 1.0f, 3);
        out[d] = wd;
      }
      *(u32x2*)(dst + (size_t)(row0 + rr) * 512 + lane * 8) = out;
      if (lane == 0) inv_scale[row0 + rr] = (am > 0.f) ? (am / 6.f) : 1.f;
    }
  }
}

DI void convert_layer_weights(const Params& P, int l, float* smf) {
  tr_family(P.w_in + (size_t)l * 1024 * 3864, 0, 3864, (u16*)(P.ws + OFF_WIN) + (size_t)l * NPAD * 1024, 0, 1024, NPAD, 1, 1, smf);
  tr_family(P.w_lift + (size_t)l * 2 * 512 * 1024, (size_t)512 * 1024, 1024, (u16*)(P.ws + OFF_LIFT) + (size_t)l * 2 * 1024 * 512,
            (size_t)1024 * 512, 512, 1024, 2, 0, smf);
  tr_family(P.w_o + (size_t)l * 1024 * 1024, 0, 1024, (u16*)(P.ws + OFF_WO) + (size_t)l * 1024 * 1024, 0, 1024, 1024, 1, 0, smf);
  tr_family(P.peer_wq + (size_t)l * 1024 * 1024, 0, 1024, (u16*)(P.ws + OFF_WQ) + (size_t)l * 1024 * 1024, 0, 1024, 1024, 1, 0, smf);
  tr_family(P.cmp_w1 + (size_t)l * 2 * 2048 * 64, (size_t)2048 * 64, 64, (u16*)(P.ws + OFF_W1T) + (size_t)l * 2 * 64 * 2048,
            (size_t)64 * 2048, 2048, 64, 2, 0, smf);
  tr_family(P.cmp_w2 + (size_t)l * 2 * 64 * 64, (size_t)64 * 64, 64, (u16*)(P.ws + OFF_W2T) + (size_t)l * 2 * 64 * 64,
            (size_t)64 * 64, 64, 64, 2, 0, smf);
  tr_family(P.w_pool + (size_t)l * 4 * 128 * 128, (size_t)128 * 128, 128, (u16*)(P.ws + OFF_WPT) + (size_t)l * 4 * 128 * 128,
            (size_t)128 * 128, 128, 128, 4, 0, smf);
  conv_plain(P.peer_keys + (size_t)l * 8 * 2 * 128 * 64, (u16*)(P.ws + OFF_KEYS) + (size_t)l * 8 * 2 * 128 * 64,
             (size_t)8 * 2 * 128 * 64);
  __syncthreads();
}
DI void convert_layer_peer(const Params& P, int l) {
#if DO_PEER
  conv_fp8_rows(P.peer_u + (size_t)l * 16384 * 1024, (unsigned char*)(P.ws + OFF_U) + (size_t)l * 16384 * 512,
                (float*)(P.ws + OFF_USC) + (size_t)l * 16384, 16384);
  conv_fp8_rows(P.peer_v + (size_t)l * 16384 * 1024, (unsigned char*)(P.ws + OFF_V) + (size_t)l * 16384 * 512,
                (float*)(P.ws + OFF_VSC) + (size_t)l * 16384, 16384);
#endif
}

DI void phase0a(const Params& P, char* smraw) {
  const int tid = otid(), nb = gridDim.x, bid = blockIdx.x;
  float* smf = (float*)smraw;
  float* MODS = (float*)(P.ws + OFF_MODS);
  {
    float* cact = smf;
    float* red = smf + 4096;
    for (int it = bid; it < 384; it += nb) {
      const int l = it / 96, ch = it % 96;
      __syncthreads();
      for (int i = tid; i < 4096; i += 256) {
        const float v = P.c[i];
        cact[i] = v / (1.f + __expf(-v));
      }
      __syncthreads();
      const int kq = tid >> 6, n = tid & 63, col = ch * 64 + n;
      float a0 = 0, a1 = 0, a2 = 0, a3 = 0;
      const float* wp = P.w_ada + ((size_t)l * 1024 + kq * 256) * 6144 + col;
#pragma unroll 32
      for (int k = 0; k < 256; ++k) {
        const float wv = __builtin_nontemporal_load(wp + (size_t)k * 6144);
        const int kk = kq * 256 + k;
        a0 += cact[kk] * wv;
        a1 += cact[1024 + kk] * wv;
        a2 += cact[2048 + kk] * wv;
        a3 += cact[3072 + kk] * wv;
      }
      red[(kq * 4 + 0) * 64 + n] = a0;
      red[(kq * 4 + 1) * 64 + n] = a1;
      red[(kq * 4 + 2) * 64 + n] = a2;
      red[(kq * 4 + 3) * 64 + n] = a3;
      __syncthreads();
      {
        const int b = tid >> 6;
        const float s = red[(0 * 4 + b) * 64 + n] + red[(1 * 4 + b) * 64 + n] + red[(2 * 4 + b) * 64 + n] +
                        red[(3 * 4 + b) * 64 + n] + P.b_ada[l * 6144 + col];
        MODS[(size_t)(l * 4 + b) * 6144 + col] = s;
      }
    }
  }
  {
    float* ROPE = (float*)(P.ws + OFF_ROPE);
    for (int i = bid * 256 + tid; i < 4096 * 8; i += nb * 256) {
      const int pos = i >> 3, fi = i & 7;
      const float inv = exp2f(-(float)fi * 0.125f * 18.931568569324174f);
      const float ang = (float)pos * inv;
      const double xr = (double)ang * 0.15915494309189535;
      const float fr = (float)(xr - floor(xr));
      ROPE[pos * 16 + fi] = __builtin_amdgcn_cosf(fr);
      ROPE[pos * 16 + 8 + fi] = __builtin_amdgcn_sinf(fr);
    }
  }
  {
    float* CB = (float*)(P.ws + OFF_CBIAS);
    float* red = smf;
    for (int it2 = bid; it2 < 64; it2 += nb) {
      const int it = it2 >> 3, kc = it2 & 7;
      __syncthreads();
      const int kq = tid >> 6, n = tid & 63;
      const float* pe = P.cmp_pe + (size_t)it * 2048 + kc * 256 + kq * 64;
      const float* w1 = P.cmp_w1 + ((size_t)it * 2048 + kc * 256 + kq * 64) * 64 + n;
      float a = 0.f;
#pragma unroll 32
      for (int k = 0; k < 64; ++k) a += pe[k] * w1[(size_t)k * 64];
      red[kq * 64 + n] = a;
      __syncthreads();
      if (tid < 64) CB[(it * 8 + kc) * 64 + tid] = red[tid] + red[64 + tid] + red[128 + tid] + red[192 + tid];
    }
  }
  convert_layer_weights(P, 0, smf);
}

DI void phase0b(const Params& P) {
  const float* MODS = (const float*)(P.ws + OFF_MODS);
  u16* H = (u16*)(P.ws + OFF_H);
  const size_t gt = (size_t)blockIdx.x * 256 + otid(), gs = (size_t)gridDim.x * 256;
  for (size_t i = gt; i < (size_t)T * 128; i += gs) {
    const size_t t = i >> 7;
    const int d0 = (int)(i & 127) * 8;
    const int b = (int)(t >> 12);
    const float* md = MODS + (size_t)b * 6144;
    const float4 a = *(const float4*)(P.x + t * 1024 + d0), c = *(const float4*)(P.x + t * 1024 + d0 + 4);
    const float xv[8] = {a.x, a.y, a.z, a.w, c.x, c.y, c.z, c.w};
    float hv[8];
#pragma unroll
    for (int j = 0; j < 8; ++j) hv[j] = xv[j] * (1.f + md[1024 + d0 + j]) + md[d0 + j];
    *(uint4*)(H + t * 1024 + d0) = make_uint4(pk2(hv[0], hv[1]), pk2(hv[2], hv[3]), pk2(hv[4], hv[5]), pk2(hv[6], hv[7]));
  }
}

DI void phase_gemm1(const Params& P, int l, char* smraw) {
  const u16* H = (const u16*)(P.ws + OFF_H);
  const u16* W = (const u16*)(P.ws + OFF_WIN) + (size_t)l * NPAD * 1024;
  const float* ROPE = (const float*)(P.ws + OFF_ROPE);
  u16* Q = (u16*)(P.ws + OFF_Q);
  u16* KV0 = (u16*)(P.ws + OFF_KV0);
  u16* K12 = (u16*)(P.ws + OFF_K12);
  u16* VT = (u16*)(P.ws + OFF_VT);
  float* GATE = (float*)(P.ws + OFF_GATE);
  u16* PIN = (u16*)(P.ws + OFF_PIN);
  u16* GM = (u16*)(P.ws + OFF_GM);
  {
    float* STATS = (float*)(P.ws + OFF_STATS);
    for (int i = blockIdx.x * 256 + otid(); i < T * 2; i += gridDim.x * 256) STATS[i] = 0.f;
  }
  GEMM_TILE_LOOP(16) {
    int nt, mt;
    gemm_tile(q, 16, mt, nt);
    const int m0 = mt * 128, n0 = nt * 256;
    f32x16 acc[2][4];
    ACC_ZERO(acc)
    gemm_main(H, 1024, W, 1024, 1024, m0, n0, acc, (u16*)smraw);
    const int tid = otid(), lane = tid & 63, w = tid >> 6, wm = w >> 1, wn = w & 1, r = lane & 31, h = lane >> 5;
    const int rb = m0 + wm * 64;
    const int t128 = 2 * nt + wn;
    if ((t128 < 4) || (t128 == 6) || (t128 == 8)) {
      const int rl = r & 15;
#pragma unroll
      for (int i = 0; i < 2; ++i)
#pragma unroll
        for (int e = 0; e < 16; ++e) {
          const int row = rb + 32 * i + crow(e, h);
          const int pos = row & (S - 1);
#pragma unroll
          for (int j = 0; j < 4; ++j) {
            const float v = acc[i][j][e];
            const float pr = __shfl_xor(v, 2);
            const int fi = 4 * (r & 1) + j;
            const float cs = ROPE[pos * 16 + fi], sn = ROPE[pos * 16 + 8 + fi];
            float o = v;
            if (rl < 2) o = v * cs - pr * sn;
            else if (rl < 4) o = pr * sn + v * cs;
            acc[i][j][e] = o;
          }
        }
    }
    if (t128 < 4) {
#pragma unroll
      for (int i = 0; i < 2; ++i)
#pragma unroll
        for (int e = 0; e < 16; ++e) {
          const int row = rb + 32 * i + crow(e, h);
          uint2 pk;
          pk.x = pk2(acc[i][0][e] * 0.125f, acc[i][1][e] * 0.125f);
          pk.y = pk2(acc[i][2][e] * 0.125f, acc[i][3][e] * 0.125f);
          *(uint2*)(Q + (size_t)row * 512 + t128 * 128 + 4 * r) = pk;
        }
    } else if (t128 < 10) {
      const int br = (t128 - 4) >> 1, kvsel = (t128 - 4) & 1;
      if (br == 0 || kvsel == 0) {
        u16* dst = (br == 0) ? (KV0 + kvsel * 128) : (K12 + (br - 1) * 128);
#pragma unroll
        for (int i = 0; i < 2; ++i)
#pragma unroll
          for (int e = 0; e < 16; ++e) {
            const int row = rb + 32 * i + crow(e, h);
            uint2 pk;
            pk.x = pk2(acc[i][0][e], acc[i][1][e]);
            pk.y = pk2(acc[i][2][e], acc[i][3][e]);
            *(uint2*)(dst + (size_t)row * 256 + 4 * r) = pk;
          }
      } else {
#pragma unroll
        for (int i = 0; i < 2; ++i)
#pragma unroll
          for (int j = 0; j < 4; ++j)
#pragma unroll
            for (int a = 0; a < 4; ++a) {
              const int row = rb + 32 * i + 8 * a + 4 * h;
              const int b = row >> 12, sp = row & (S - 1);
              const int g = r >> 4, d = 4 * (r & 15) + j;
              uint2 pk;
              pk.x = pk2(acc[i][j][4 * a], acc[i][j][4 * a + 1]);
              pk.y = pk2(acc[i][j][4 * a + 2], acc[i][j][4 * a + 3]);
              *(uint2*)(VT + ((size_t)(((b * 2 + (br - 1)) * 2 + g) * 64 + d)) * S + sp) = pk;
            }
      }
    } else if (t128 < 14) {
#pragma unroll
      for (int i = 0; i < 2; ++i)
#pragma unroll
        for (int e = 0; e < 16; ++e) {
          const int row = rb + 32 * i + crow(e, h);
          uint2 pk;
          pk.x = pk2(acc[i][0][e], acc[i][1][e]);
          pk.y = pk2(acc[i][2][e], acc[i][3][e]);
          *(uint2*)(PIN + (size_t)row * 512 + (t128 - 10) * 128 + 4 * r) = pk;
        }
    } else if (t128 < 30) {
#pragma unroll
      for (int i = 0; i < 2; ++i)
#pragma unroll
        for (int e = 0; e < 16; ++e) {
          const int row = rb + 32 * i + crow(e, h);
          uint2 pk;
          pk.x = pk2(sigmoidf_(acc[i][0][e]), sigmoidf_(acc[i][1][e]));
          pk.y = pk2(sigmoidf_(acc[i][2][e]), sigmoidf_(acc[i][3][e]));
          *(uint2*)(GM + (size_t)row * 2048 + (t128 - 14) * 128 + 4 * r) = pk;
        }
    } else if (t128 == 30) {
      if (r < 6) {
#pragma unroll
        for (int i = 0; i < 2; ++i)
#pragma unroll
          for (int e = 0; e < 16; ++e) {
            const int row = rb + 32 * i + crow(e, h);
            *(float4*)(GATE + (size_t)row * 24 + 4 * r) = make_float4(sigmoidf_(acc[i][0][e]), sigmoidf_(acc[i][1][e]),
                                                                    sigmoidf_(acc[i][2][e]), sigmoidf_(acc[i][3][e]));
          }
      }
    }
  }
}

DI void phase_cmp_pool(const Params& P, int l, char* smraw) {
  const int tid = otid(), lane = tid & 63, w = tid >> 6, r = lane & 31, h = lane >> 5;
  const u16* KV0 = (const u16*)(P.ws + OFF_KV0);
  const u16* W1T = (const u16*)(P.ws + OFF_W1T);
  const u16* W2T = (const u16*)(P.ws + OFF_W2T);
  const float* CB = (const float*)(P.ws + OFF_CBIAS);
  const float* ROPE = (const float*)(P.ws + OFF_ROPE);
  u16* KC = (u16*)(P.ws + OFF_KC);
  u16* VCT = (u16*)(P.ws + OFF_VCT);
  const u16* PIN = (const u16*)(P.ws + OFF_PIN);
  const u16* WPT = (const u16*)(P.ws + OFF_WPT);
  u16* OPOOL = (u16*)(P.ws + OFF_OPOOL);
  const int NCMP = 128, NPOOL = 1024;
  for (int it = blockIdx.x; it < NCMP + NPOOL; it += gridDim.x) {
    __syncthreads();
    if (it < NCMP) {
      const int ct = it & 7, g = (it >> 3) & 1, b = (it >> 4) & 3, kvsel = it >> 6;
      float* red = (float*)smraw;
      u16* G1 = (u16*)(smraw + 32768);
      const u16* w1 = W1T + (size_t)(l * 2 + kvsel) * 64 * 2048;
      int c = ct * 32 + r;
      if (c > 254) c = 254;
      const u16* abase = KV0 + ((size_t)b * S + 16 * c) * 256 + kvsel * 128 + g * 64;
      f32x16 acc0 = zero16(), acc1 = zero16();
#pragma unroll 16
      for (int ks = 0; ks < 32; ++ks) {
        const int k = w * 512 + 16 * ks + 8 * h;
        const int ll = k >> 6, d = k & 63;
        const bf16x8 a = *(const bf16x8*)(abase + (size_t)ll * 256 + d);
        const bf16x8 b0 = *(const bf16x8*)(w1 + (size_t)r * 2048 + k);
        const bf16x8 b1 = *(const bf16x8*)(w1 + (size_t)(32 + r) * 2048 + k);
        acc0 = MFMA32(a, b0, acc0);
        acc1 = MFMA32(a, b1, acc1);
      }
#pragma unroll
      for (int e = 0; e < 16; ++e) {
        red[(w * 32 + crow(e, h)) * 64 + r] = acc0[e];
        red[(w * 32 + crow(e, h)) * 64 + 32 + r] = acc1[e];
      }
      __syncthreads();
      const float* cb = CB + (l * 2 + kvsel) * 512;
#pragma unroll
      for (int i = 0; i < 8; ++i) {
        const int idx = tid + 256 * i;
        const int row = idx >> 6, col = idx & 63;
        const float bias = ((cb[col] + cb[64 + col]) + (cb[128 + col] + cb[192 + col])) +
                           ((cb[256 + col] + cb[320 + col]) + (cb[384 + col] + cb[448 + col]));
        const float v = red[idx] + red[2048 + idx] + red[4096 + idx] + red[6144 + idx] + bias;
        G1[row * 72 + col] = f2bf(gelu_tanh(v));
      }
      __syncthreads();
      if (w < 2) {
        const u16* w2 = W2T + (size_t)(l * 2 + kvsel) * 64 * 64;
        f32x16 o = zero16();
#pragma unroll
        for (int ks = 0; ks < 4; ++ks) {
          const bf16x8 a = *(const bf16x8*)(G1 + r * 72 + 16 * ks + 8 * h);
          const bf16x8 bb = *(const bf16x8*)(w2 + (size_t)(32 * w + r) * 64 + 16 * ks + 8 * h);
          o = MFMA32(a, bb, o);
        }
        const int n = 32 * w + r;
        if (kvsel == 0) {
#pragma unroll
          for (int e = 0; e < 16; ++e) {
            const int cc = ct * 32 + crow(e, h);
            float v = o[e];
            const float pr = __shfl_xor(v, 8);
            if (w == 0 && r < 16) {
              const int pos = (16 * cc + 31) & (S - 1);
              const float cs = ROPE[pos * 16 + (r & 7)], sn = ROPE[pos * 16 + 8 + (r & 7)];
              v = (r < 8) ? (v * cs - pr * sn) : (pr * sn + v * cs);
            }
            if (cc > 254) v = 0.f;
            KC[((size_t)(b * 2 + g) * 256 + cc) * 64 + n] = f2bf(v);
          }
        } else {
#pragma unroll
          for (int a = 0; a < 4; ++a) {
            const int cc = ct * 32 + 8 * a + 4 * h;
            float v0 = o[4 * a], v1 = o[4 * a + 1], v2 = o[4 * a + 2], v3 = o[4 * a + 3];
            if (cc + 3 > 254) v3 = 0.f;
            uint2 pk;
            pk.x = pk2(v0, v1);
            pk.y = pk2(v2, v3);
            *(uint2*)(VCT + ((size_t)(b * 2 + g) * 64 + n) * 256 + cc) = pk;
          }
        }
      }
    } else {
      const int pi = it - NCMP;
      const int g = pi & 3, tt = pi >> 2;
      const int t0 = tt * 64;
      const int s0 = t0 & (S - 1);
      u16* Pl = (u16*)smraw;
      {
        const int c = tid & 127, half = tid >> 7;
        const int win = 2 << g;
        const u16* pc = PIN + (size_t)(t0 - s0) * 512 + g * 128 + c;
        const int sp0 = s0 + half * 32;
        float sum = 0.f;
        for (int u = sp0 - win; u < sp0; ++u)
          if (u >= 0) sum += bf2f(pc[(size_t)u * 512]);
#pragma unroll 1
        for (int k0 = 0; k0 < 32; k0 += 16) {
          float pv[16], po[16];
#pragma unroll
          for (int k = 0; k < 16; ++k) {
            const int sp = sp0 + k0 + k;
            pv[k] = bf2f(pc[(size_t)sp * 512]);
            po[k] = (sp - win >= 0) ? bf2f(pc[(size_t)(sp - win) * 512]) : 0.f;
          }
#pragma unroll
          for (int k = 0; k < 16; ++k) {
            const int sp = sp0 + k0 + k;
            sum += pv[k];
            sum -= po[k];
            const float cnt = (float)((sp + 1 < win) ? (sp + 1) : win);
            Pl[(half * 32 + k0 + k) * 136 + c] = f2bf(sum / cnt - pv[k]);
          }
        }
      }
      __syncthreads();
      const u16* wp = WPT + (size_t)(l * 4 + g) * 128 * 128;
      f32x16 a0 = zero16(), a1 = zero16();
#pragma unroll
      for (int ks = 0; ks < 8; ++ks) {
        const bf16x8 bb = *(const bf16x8*)(wp + (size_t)(32 * w + r) * 128 + 16 * ks + 8 * h);
        const bf16x8 x0 = *(const bf16x8*)(Pl + r * 136 + 16 * ks + 8 * h);
        const bf16x8 x1 = *(const bf16x8*)(Pl + (32 + r) * 136 + 16 * ks + 8 * h);
        a0 = MFMA32(x0, bb, a0);
        a1 = MFMA32(x1, bb, a1);
      }
      const int n = g * 128 + 32 * w + r;
      const float psc = P.pool_scale[l * 512 + n];
#pragma unroll
      for (int e = 0; e < 16; ++e) {
        OPOOL[(size_t)(t0 + crow(e, h)) * 512 + n] = f2bf(a0[e] * psc);
        OPOOL[(size_t)(t0 + 32 + crow(e, h)) * 512 + n] = f2bf(a1[e] * psc);
      }
    }
  }
}

struct TileRegs { u32x4 k[2], v[2]; };
DI void tile_gload(TileRegs& t, const u16* Kb, size_t ks, const u16* Vb, size_t vs, int tid_) {
  const int tid = otid();
#pragma unroll
  for (int i = 0; i < 2; ++i) {
    const int c = tid + 256 * i, row = c >> 3, c8 = (c & 7) * 8;
    t.k[i] = *(const u32x4*)(Kb + (size_t)row * ks + c8);
    t.v[i] = *(const u32x4*)(Vb + (size_t)row * vs + c8);
  }
}
DI void tile_sstore(const TileRegs& t, u16* Kb, u16* Vb, int tid_) {
  const int tid = otid();
#pragma unroll
  for (int i = 0; i < 2; ++i) {
    const int c = tid + 256 * i, row = c >> 3, c8 = (c & 7) * 8;
    *(u32x4*)(Kb + row * 72 + c8) = t.k[i];
    *(u32x4*)(Vb + row * 72 + c8) = t.v[i];
  }
}

template <int MODE>
DI void attn_step(const u16* Kb, const u16* Vb, const bf16x8 (&qf)[4], f32x16 (&o)[2], float& m, float& l, int hi, int lo,
                  bool act) {
  const int ln_ = otid() & 63, r = ln_ & 31, h = ln_ >> 5;
  f32x16 s[2];
  s[0] = zero16();
  s[1] = zero16();
#pragma unroll
  for (int ks = 0; ks < 4; ++ks) {
    const bf16x8 k0 = *(const bf16x8*)(Kb + r * 72 + 16 * ks + 8 * h);
    const bf16x8 k1 = *(const bf16x8*)(Kb + (32 + r) * 72 + 16 * ks + 8 * h);
    s[0] = MFMA32(k0, qf[ks], s[0]);
    s[1] = MFMA32(k1, qf[ks], s[1]);
  }
  float mx = -1e30f;
#pragma unroll
  for (int mt = 0; mt < 2; ++mt)
#pragma unroll
    for (int e = 0; e < 16; ++e) {
      float sv = s[mt][e];
      const int kc = 32 * mt + (e & 3) + 8 * (e >> 2);
      if (MODE & 1) sv = (kc <= hi) ? sv : -1e30f;
      if (MODE & 2) sv = (kc >= lo) ? sv : -1e30f;
      s[mt][e] = sv;
      mx = fmaxf(mx, sv);
    }
  mx = fmaxf(mx, __shfl_xor(mx, 32));
  if (MODE & 4) mx = act ? mx : -1e30f;
  const float mnew = fmaxf(m, mx);
  const float alpha = ex2((m - mnew) * L2E);
  m = mnew;
  float mL = fmaxf(mnew, -1e20f) * L2E;
  if (MODE & 4) mL = act ? mL : 1e30f;
  if (__builtin_amdgcn_ballot_w64(alpha != 1.f)) {
#pragma unroll
    for (int dt = 0; dt < 2; ++dt)
#pragma unroll
      for (int e = 0; e < 16; ++e) o[dt][e] *= alpha;
  }
  bf16x8 av[2][2][2];
#pragma unroll
  for (int mt = 0; mt < 2; ++mt)
#pragma unroll
    for (int s2 = 0; s2 < 2; ++s2)
#pragma unroll
      for (int dt = 0; dt < 2; ++dt) {
        const u16* vp = Vb + (32 * dt + r) * 72 + 32 * mt + 16 * s2 + 4 * h;
        const s16x4 lo4 = *(const s16x4*)vp;
        const s16x4 hi4 = *(const s16x4*)(vp + 8);
        av[mt][s2][dt] = __builtin_shufflevector(lo4, hi4, 0, 1, 2, 3, 4, 5, 6, 7);
      }
  float rs = 0.f;
#pragma unroll
  for (int mt = 0; mt < 2; ++mt)
#pragma unroll
    for (int s2 = 0; s2 < 2; ++s2) {
      float p[8];
#pragma unroll
      for (int e = 0; e < 8; ++e) {
        p[e] = ex2(fmaf(s[mt][8 * s2 + e], L2E, -mL));
        rs += p[e];
      }
      u32x4 u;
      u.x = pk2(p[0], p[1]);
      u.y = pk2(p[2], p[3]);
      u.z = pk2(p[4], p[5]);
      u.w = pk2(p[6], p[7]);
      const bf16x8 pb = __builtin_bit_cast(bf16x8, u);
      o[0] = MFMA32(av[mt][s2][0], pb, o[0]);
      o[1] = MFMA32(av[mt][s2][1], pb, o[1]);
      __builtin_amdgcn_sched_barrier(0);
    }
  rs += __shfl_xor(rs, 32);
  l = l * alpha + rs;
}

template <int WM>
DI void attn_flush(const Params& P, f32x16 (&o)[2], float& m, float& l, unsigned (&pacc)[16], int tq0, int g, int br) {
  const int tid = otid(), lane = tid & 63, w = tid >> 6, r = lane & 31, h = lane >> 5;
  const float* GATE = (const float*)(P.ws + OFF_GATE);
  u16* OATT = (u16*)(P.ws + OFF_OATT);
  const int head = g * 4 + w;
  const size_t t = (size_t)tq0 + r;
  const float inv = (l > 0.f) ? (1.f / l) : 0.f;
  const float sc = inv * GATE[t * 24 + g * 12 + w * 3 + br];
  unsigned q0[8], q1[8];
#pragma unroll
  for (int dt = 0; dt < 2; ++dt)
#pragma unroll
    for (int a = 0; a < 4; ++a) {
      float v0 = o[dt][4 * a] * sc, v1 = o[dt][4 * a + 1] * sc, v2 = o[dt][4 * a + 2] * sc, v3 = o[dt][4 * a + 3] * sc;
      const int pi = (dt * 4 + a) * 2;
      if (WM >= 1) {
        v0 += bflo(pacc[pi]); v1 += bfhi(pacc[pi]); v2 += bflo(pacc[pi + 1]); v3 += bfhi(pacc[pi + 1]);
      }
      q0[dt * 4 + a] = pk2(v0, v1);
      q1[dt * 4 + a] = pk2(v2, v3);
      if (WM <= 1) {
        pacc[pi] = q0[dt * 4 + a];
        pacc[pi + 1] = q1[dt * 4 + a];
      }
    }
  if (WM == 2) {
#pragma unroll
    for (int dt = 0; dt < 2; ++dt)
#pragma unroll
      for (int k = 0; k < 2; ++k) {
        const u32x2 ra = __builtin_amdgcn_permlane32_swap(q0[dt * 4 + 2 * k], q0[dt * 4 + 2 * k + 1], false, false);
        const u32x2 rb = __builtin_amdgcn_permlane32_swap(q1[dt * 4 + 2 * k], q1[dt * 4 + 2 * k + 1], false, false);
        const size_t idx = t * 512 + head * 64 + 32 * dt + 16 * k + 8 * h;
        *(uint4*)(OATT + idx) = make_uint4(ra[0], rb[0], ra[1], rb[1]);
      }
  }
  m = -1e30f;
  l = 0.f;
  o[0] = zero16();
  o[1] = zero16();
}

DI void phase_attn_items(const Params& P, char* smraw) {
  const u16* Q = (const u16*)(P.ws + OFF_Q);
  const u16* K12 = (const u16*)(P.ws + OFF_K12);
  const u16* VT = (const u16*)(P.ws + OFF_VT);
  const u16* KC = (const u16*)(P.ws + OFF_KC);
  const u16* VCT = (const u16*)(P.ws + OFF_VCT);
  u16* Ks = (u16*)smraw;
  u16* Vs = Ks + 2 * 64 * 72;
  float* imp = (float*)(smraw + 36864);
  unsigned* selm = (unsigned*)(smraw + 36864 + 8192);
  unsigned* uni = selm + 64;
  for (int pp = blockIdx.x; pp < 1024; pp += gridDim.x) {
    const int phalf = pp & 511;
    const int item = (pp < 512) ? phalf : (1016 - (phalf & ~7) + (phalf & 7));
    const int tid = otid(), lane = tid & 63, w = tid >> 6, r = lane & 31, h = lane >> 5;
    const int cur = 63 - (item >> 4);
    const int half = (item >> 3) & 1, b = (item >> 1) & 3, g = item & 1;
    const int qi = 32 * half + r;
    const int tq0 = b * S + cur * 64 + 32 * half;
    const int head = g * 4 + w;
    __syncthreads();
    for (int i = tid; i < 2048; i += 256) imp[i] = 0.f;
    if (tid < 2) uni[tid] = 0u;
    bf16x8 qf[4];
#pragma unroll
    for (int ks = 0; ks < 4; ++ks)
      qf[ks] = *(const bf16x8*)(Q + (size_t)(tq0 + r) * 512 + head * 64 + 16 * ks + 8 * h);
    f32x16 o[2];
    o[0] = zero16();
    o[1] = zero16();
    float m = -1e30f, l = 0.f;
    TileRegs tr;
    const int nct = ((4 * cur + 2) >> 6) + 1;
    const u16* kcb = KC + (size_t)(b * 2 + g) * 256 * 64;
    const u16* vcb = VCT + (size_t)(b * 2 + g) * 64 * 256;
    const int hcmp = ((cur * 64 + qi - 31) >> 4) - 4 * h;
    int buf = 0;
    tile_gload(tr, kcb, 64, vcb, 256, tid);
    __syncthreads();
    tile_sstore(tr, Ks, Vs, tid);
    __syncthreads();
    for (int i = 0; i < nct; ++i) {
      if (i + 1 < nct) tile_gload(tr, kcb + (size_t)(i + 1) * 64 * 64, 64, vcb + (i + 1) * 64, 256, tid);
      __builtin_amdgcn_sched_barrier(0);
      attn_step<1>(Ks + buf * 4608, Vs + buf * 4608, qf, o, m, l, hcmp - 64 * i, 0, true);
      if (i + 1 < nct) tile_sstore(tr, Ks + (buf ^ 1) * 4608, Vs + (buf ^ 1) * 4608, tid);
      __syncthreads();
      buf ^= 1;
    }
    const float cm = fmaxf(m, -1e20f) * L2E;
    const float cinv = (l > 0.f) ? (1.f / l) : 0.f;
    unsigned pacc[16];
    attn_flush<0>(P, o, m, l, pacc, tq0, g, 0);
    tile_gload(tr, kcb, 64, vcb, 256, tid);
    tile_sstore(tr, Ks + buf * 4608, Vs + buf * 4608, tid);
    __syncthreads();
    for (int i = 0; i < nct; ++i) {
      if (i + 1 < nct) tile_gload(tr, kcb + (size_t)(i + 1) * 64 * 64, 64, vcb + (i + 1) * 64, 256, tid);
      __builtin_amdgcn_sched_barrier(0);
      {
        const u16* Kb = Ks + buf * 4608;
        f32x16 s[2];
        s[0] = zero16();
        s[1] = zero16();
#pragma unroll
        for (int ks = 0; ks < 4; ++ks) {
          const bf16x8 k0 = *(const bf16x8*)(Kb + r * 72 + 16 * ks + 8 * h);
          const bf16x8 k1 = *(const bf16x8*)(Kb + (32 + r) * 72 + 16 * ks + 8 * h);
          s[0] = MFMA32(k0, qf[ks], s[0]);
          s[1] = MFMA32(k1, qf[ks], s[1]);
        }
        const int hq = hcmp - 64 * i;
#pragma unroll
        for (int mt = 0; mt < 2; ++mt)
#pragma unroll
          for (int a = 0; a < 4; ++a) {
            float p[4];
#pragma unroll
            for (int q = 0; q < 4; ++q) {
              const int kc = 32 * mt + 8 * a + q;
              const float pv = ex2(fmaf(s[mt][4 * a + q], L2E, -cm)) * cinv;
              p[q] = (kc <= hq) ? pv : 0.f;
            }
            const int j = 16 * i + 8 * mt + 2 * a + h;
            atomicAdd(&imp[j * 32 + r], 2.f * (p[0] + p[1] + p[2]) + p[3]);
            if (j + 1 < 64) atomicAdd(&imp[(j + 1) * 32 + r], p[3]);
          }
      }
      if (i + 1 < nct) tile_sstore(tr, Ks + (buf ^ 1) * 4608, Vs + (buf ^ 1) * 4608, tid);
      __syncthreads();
      buf ^= 1;
    }
    {
      const int q = 8 * w + (lane & 7), part = lane >> 3;
      unsigned long long mask;
      if (cur <= 15) {
        mask = (2ULL << cur) - 1ULL;
      } else {
        mask = 1ULL | (1ULL << cur);
        for (int itn = 0; itn < 14; ++itn) {
          unsigned best = 0u;
#pragma unroll
          for (int jj = 0; jj < 8; ++jj) {
            const int j = part * 8 + jj;
            const unsigned k = (__float_as_uint(imp[j * 32 + q]) & ~63u) | (unsigned)(63 - j);
            const bool ok = (j >= 1) && (j < cur) && !((mask >> j) & 1ULL);
            best = umax_(best, ok ? k : 0u);
          }
          best = umax_(best, shx(best, 8));
          best = umax_(best, shx(best, 16));
          best = umax_(best, shx(best, 32));
          mask |= 1ULL << (63 - (int)(best & 63u));
        }
      }
      if (part == 0) {
        selm[q * 2] = (unsigned)mask;
        selm[q * 2 + 1] = (unsigned)(mask >> 32);
        atomicOr(&uni[0], (unsigned)mask);
        atomicOr(&uni[1], (unsigned)(mask >> 32));
      }
    }
    __syncthreads();
    unsigned long long um = ((unsigned long long)uni[1] << 32) | uni[0];
    um &= (2ULL << cur) - 1ULL;
    const unsigned long long qm = ((unsigned long long)selm[r * 2 + 1] << 32) | selm[r * 2];
    {
      const u16* kb = K12 + (size_t)(b * S) * 256 + 0 * 128 + g * 64;
      const u16* vb = VT + (size_t)((b * 2 + 0) * 2 + g) * 64 * S;
      int j = __ffsll((long long)um) - 1;
      tile_gload(tr, kb + (size_t)(j * 64) * 256, 256, vb + j * 64, S, tid);
      tile_sstore(tr, Ks + buf * 4608, Vs + buf * 4608, tid);
      __syncthreads();
      while (true) {
        um &= um - 1ULL;
        const int jn = um ? (__ffsll((long long)um) - 1) : -1;
        if (jn >= 0) tile_gload(tr, kb + (size_t)(jn * 64) * 256, 256, vb + jn * 64, S, tid);
        __builtin_amdgcn_sched_barrier(0);
        if (j == cur) {
          attn_step<1>(Ks + buf * 4608, Vs + buf * 4608, qf, o, m, l, qi - 4 * h, 0, true);
        } else {
          attn_step<4>(Ks + buf * 4608, Vs + buf * 4608, qf, o, m, l, 0, 0, (bool)((qm >> j) & 1ULL));
        }
        if (jn >= 0) tile_sstore(tr, Ks + (buf ^ 1) * 4608, Vs + (buf ^ 1) * 4608, tid);
        __syncthreads();
        buf ^= 1;
        if (jn < 0) break;
        j = jn;
      }
      attn_flush<1>(P, o, m, l, pacc, tq0, g, 1);
    }
    {
      const u16* kb = K12 + (size_t)(b * S) * 256 + 1 * 128 + g * 64;
      const u16* vb = VT + (size_t)((b * 2 + 1) * 2 + g) * 64 * S;
      const int j0 = (cur - 8 > 0) ? (cur - 8) : 0;
      tile_gload(tr, kb + (size_t)(j0 * 64) * 256, 256, vb + j0 * 64, S, tid);
      tile_sstore(tr, Ks + buf * 4608, Vs + buf * 4608, tid);
      __syncthreads();
      for (int j = j0; j <= cur; ++j) {
        if (j + 1 <= cur) tile_gload(tr, kb + (size_t)((j + 1) * 64) * 256, 256, vb + (j + 1) * 64, S, tid);
        __builtin_amdgcn_sched_barrier(0);
        if (j == cur) {
          attn_step<1>(Ks + buf * 4608, Vs + buf * 4608, qf, o, m, l, qi - 4 * h, 0, true);
        } else if (j == cur - 8) {
          attn_step<2>(Ks + buf * 4608, Vs + buf * 4608, qf, o, m, l, 0, qi + 1 - 4 * h, true);
        } else {
          attn_step<0>(Ks + buf * 4608, Vs + buf * 4608, qf, o, m, l, 0, 0, true);
        }
        if (j + 1 <= cur) tile_sstore(tr, Ks + (buf ^ 1) * 4608, Vs + (buf ^ 1) * 4608, tid);
        __syncthreads();
        buf ^= 1;
      }
      attn_flush<2>(P, o, m, l, pacc, tq0, g, 2);
    }
  }
}

#define EPI_IDS const int tid = otid(), lane = tid & 63, w = tid >> 6, wm = w >> 1, wn = w & 1, r = lane & 31, h = lane >> 5;
#define EPI_ROWS                                      \
  _Pragma("unroll") for (int i = 0; i < 2; ++i)       \
  _Pragma("unroll") for (int e = 0; e < 16; ++e)

DI void phase_gemm2_pool(const Params& P, int l, char* smraw) {
  const u16* OPOOL = (const u16*)(P.ws + OFF_OPOOL);
  const u16* L1 = (const u16*)(P.ws + OFF_LIFT) + (size_t)(l * 2 + 1) * 1024 * 512;
  const u16* GM = (const u16*)(P.ws + OFF_GM);
  u16* MERGED = (u16*)(P.ws + OFF_MERGED);
  GEMM_TILE_LOOP(4) {
    int nt, mt;
    gemm_tile(q, 4, mt, nt);
    const int m0 = mt * 128, n0 = nt * 256;
    f32x16 acc[2][4];
    ACC_ZERO(acc)
    gemm_main(OPOOL, 512, L1, 512, 512, m0, n0, acc, (u16*)smraw);
    {
      EPI_IDS
      EPI_ROWS {
        const int row = m0 + wm * 64 + 32 * i + crow(e, h), col = n0 + wn * 128 + 4 * r;
        const uint2 gv = *(const uint2*)(GM + (size_t)row * 2048 + 1024 + col);
        uint2 pk;
        pk.x = pk2(acc[i][0][e] * bflo(gv.x), acc[i][1][e] * bfhi(gv.x));
        pk.y = pk2(acc[i][2][e] * bflo(gv.y), acc[i][3][e] * bfhi(gv.y));
        *(uint2*)(MERGED + (size_t)row * 1024 + col) = pk;
      }
    }
  }
  __syncthreads();
}

DI void phase_gemm2(const Params& P, int l, char* smraw) {
  const u16* OATT = (const u16*)(P.ws + OFF_OATT);
  const u16* L0 = (const u16*)(P.ws + OFF_LIFT) + (size_t)(l * 2 + 0) * 1024 * 512;
  const u16* GM = (const u16*)(P.ws + OFF_GM);
  u16* MERGED = (u16*)(P.ws + OFF_MERGED);
  GEMM_TILE_LOOP(4) {
    int nt, mt;
    gemm_tile(q, 4, mt, nt);
    const int m0 = mt * 128, n0 = nt * 256;
    f32x16 acc[2][4];
    ACC_ZERO(acc)
    gemm_main(OATT, 512, L0, 512, 512, m0, n0, acc, (u16*)smraw);
    {
      EPI_IDS
      EPI_ROWS {
        const int row = m0 + wm * 64 + 32 * i + crow(e, h), col = n0 + wn * 128 + 4 * r;
        const uint2 gv = *(const uint2*)(GM + (size_t)row * 2048 + col);
        const uint2 mv = *(const uint2*)(MERGED + (size_t)row * 1024 + col);
        uint2 pk;
        pk.x = pk2(bflo(mv.x) + acc[i][0][e] * bflo(gv.x), bfhi(mv.x) + acc[i][1][e] * bfhi(gv.x));
        pk.y = pk2(bflo(mv.y) + acc[i][2][e] * bflo(gv.y), bfhi(mv.y) + acc[i][3][e] * bfhi(gv.y));
        *(uint2*)(MERGED + (size_t)row * 1024 + col) = pk;
      }
    }
  }
}

DI void phase_attn(const Params& P, int l, char* smraw) {
  const bool side_first = (blockIdx.x >> 8) & 1;
  if (side_first) {
    phase_gemm2_pool(P, l, smraw);
    convert_layer_peer(P, l);
    if (l + 1 < NL) convert_layer_weights(P, l + 1, (float*)smraw);
  }
  phase_attn_items(P, smraw);
  if (!side_first) {
    __syncthreads();
    phase_gemm2_pool(P, l, smraw);
    convert_layer_peer(P, l);
    if (l + 1 < NL) convert_layer_weights(P, l + 1, (float*)smraw);
  }
}

DI float xsum32(float (&p)[32], int lane) {
  float q16[16], q8[8], q4[4], q2[2];
  const bool b16 = lane & 16, b8 = lane & 8, b4 = lane & 4, b2 = lane & 2, b1 = lane & 1;
#pragma unroll
  for (int i = 0; i < 16; ++i) { const float k = b16 ? p[16 + i] : p[i], sd = b16 ? p[i] : p[16 + i]; q16[i] = k + __shfl_xor(sd, 16); }
#pragma unroll
  for (int i = 0; i < 8; ++i) { const float k = b8 ? q16[8 + i] : q16[i], sd = b8 ? q16[i] : q16[8 + i]; q8[i] = k + __shfl_xor(sd, 8); }
#pragma unroll
  for (int i = 0; i < 4; ++i) { const float k = b4 ? q8[4 + i] : q8[i], sd = b4 ? q8[i] : q8[4 + i]; q4[i] = k + __shfl_xor(sd, 4); }
#pragma unroll
  for (int i = 0; i < 2; ++i) { const float k = b2 ? q4[2 + i] : q4[i], sd = b2 ? q4[i] : q4[2 + i]; q2[i] = k + __shfl_xor(sd, 2); }
  const float k = b1 ? q2[1] : q2[0], sd = b1 ? q2[0] : q2[1];
  return k + __shfl_xor(sd, 1);
}

DI void phase_gemm3(const Params& P, int l, char* smraw) {
  const u16* MERGED = (const u16*)(P.ws + OFF_MERGED);
  const u16* WO = (const u16*)(P.ws + OFF_WO) + (size_t)l * 1024 * 1024;
  const float* MODS = (const float*)(P.ws + OFF_MODS);
  const float* Xs = (l == 0) ? P.x : (const float*)(P.ws + OFF_X);
  float* X = (float*)(P.ws + OFF_X);
  u16* H = (u16*)(P.ws + OFF_H);
  float* STATS = (float*)(P.ws + OFF_STATS);
  unsigned* MTC = (unsigned*)(P.ws + OFF_BAR) + MT_CNT_WORD;
  GEMM_TILE_LOOP(4) {
    int nt, mt;
    gemm_tile(q, 4, mt, nt);
    const int m0 = mt * 128, n0 = nt * 256;
    f32x16 acc[2][4];
    ACC_ZERO(acc)
#if DO_MIXER
    gemm_main(MERGED, 1024, WO, 1024, 1024, m0, n0, acc, (u16*)smraw);
#endif
    const int b = m0 >> 12;
    const float* md = MODS + (size_t)(l * 4 + b) * 6144;
    const int tid = otid(), lane = tid & 63, w = tid >> 6, wm = w >> 1, wn = w & 1, r = lane & 31, h = lane >> 5;
    const int cb = n0 + wn * 128 + 4 * r;
    {
      const float4 g1v = *(const float4*)(md + 2048 + cb);
#pragma unroll
      for (int i = 0; i < 2; ++i)
#pragma unroll
        for (int e = 0; e < 16; ++e) {
          const unsigned off = (unsigned)((m0 + wm * 64 + 32 * i + crow(e, h)) * 1024 + cb);
          const float4 xv = *(const float4*)(Xs + off);
          acc[i][0][e] = DN_ALPHA * xv.x + g1v.x * acc[i][0][e];
          acc[i][1][e] = DN_ALPHA * xv.y + g1v.y * acc[i][1][e];
          acc[i][2][e] = DN_ALPHA * xv.z + g1v.z * acc[i][2][e];
          acc[i][3][e] = DN_ALPHA * xv.w + g1v.w * acc[i][3][e];
          if ((e & 7) == 7) __builtin_amdgcn_sched_barrier(0);
        }
    }
    {
      float ts, tq;
      {
        float ps[32];
#pragma unroll
        for (int i = 0; i < 2; ++i)
#pragma unroll
          for (int e = 0; e < 16; ++e) ps[i * 16 + e] = (acc[i][0][e] + acc[i][1][e]) + (acc[i][2][e] + acc[i][3][e]);
        ts = xsum32(ps, lane);
      }
      __builtin_amdgcn_sched_barrier(0);
      {
        float pq[32];
#pragma unroll
        for (int i = 0; i < 2; ++i)
#pragma unroll
          for (int e = 0; e < 16; ++e)
            pq[i * 16 + e] = (acc[i][0][e] * acc[i][0][e] + acc[i][1][e] * acc[i][1][e]) +
                             (acc[i][2][e] * acc[i][2][e] + acc[i][3][e] * acc[i][3][e]);
        tq = xsum32(pq, lane);
      }
      __builtin_amdgcn_sched_barrier(0);
      const int row = m0 + wm * 64 + 32 * (r >> 4) + crow(r & 15, h);
      atomicAdd(&STATS[(size_t)row * 2], ts);
      atomicAdd(&STATS[(size_t)row * 2 + 1], tq);
    }
    asm volatile("s_waitcnt vmcnt(0)" ::: "memory");
    __syncthreads();
    if (otid() == 0) {
      __hip_atomic_fetch_add(&MTC[mt], 1u, __ATOMIC_RELEASE, __HIP_MEMORY_SCOPE_AGENT);
      const unsigned target = 4u * (unsigned)(l + 1);
      unsigned spins = 0;
      while (__hip_atomic_load(&MTC[mt], __ATOMIC_ACQUIRE, __HIP_MEMORY_SCOPE_AGENT) < target) {
        __builtin_amdgcn_s_sleep(1);
        if (++spins > (1u << 22)) break;
      }
    }
    __syncthreads();
    {
      const int tid2 = otid(), lane2 = tid2 & 63, w2 = tid2 >> 6, wm = w2 >> 1, wn = w2 & 1, r = lane2 & 31, h = lane2 >> 5;
      const int cb = n0 + wn * 128 + 4 * r;
      const float4 gm4 = *(const float4*)(P.ln_g + (size_t)(l * 2 + 0) * 1024 + cb);
      const float4 bt4 = *(const float4*)(P.ln_b + (size_t)(l * 2 + 0) * 1024 + cb);
      const float4 sh4 = *(const float4*)(md + 3072 + cb);
      const float4 sc4 = *(const float4*)(md + 4096 + cb);
#pragma unroll
      for (int i = 0; i < 2; ++i)
#pragma unroll
        for (int e = 0; e < 16; ++e) {
          const int row = m0 + wm * 64 + 32 * i + crow(e, h);
          const float sm_ = __hip_atomic_load(&STATS[(size_t)row * 2], __ATOMIC_RELAXED, __HIP_MEMORY_SCOPE_AGENT);
          const float sq_ = __hip_atomic_load(&STATS[(size_t)row * 2 + 1], __ATOMIC_RELAXED, __HIP_MEMORY_SCOPE_AGENT);
          const float mu = sm_ * (1.f / 1024.f);
          const float var = fmaxf(sq_ * (1.f / 1024.f) - mu * mu, 0.f);
          const float rstd = rsqrtf(var + 1e-5f);
          const float x0 = (acc[i][0][e] - mu) * rstd * gm4.x + bt4.x;
          const float x1 = (acc[i][1][e] - mu) * rstd * gm4.y + bt4.y;
          const float x2 = (acc[i][2][e] - mu) * rstd * gm4.z + bt4.z;
          const float x3 = (acc[i][3][e] - mu) * rstd * gm4.w + bt4.w;
          const unsigned idx = (unsigned)(row * 1024 + cb);
          *(float4*)(X + idx) = make_float4(x0, x1, x2, x3);
          uint2 pk;
          pk.x = pk2(x0 * (1.f + sc4.x) + sh4.x, x1 * (1.f + sc4.y) + sh4.y);
          pk.y = pk2(x2 * (1.f + sc4.z) + sh4.z, x3 * (1.f + sc4.w) + sh4.w);
          *(uint2*)(H + idx) = pk;
        }
    }
  }
}

template <int LAYOUT>
DI void ln_finish(float (&v)[16], size_t t, int lane, const float* gam, const float* bet, const float* sh,
                  const float* sc, float* Xo, u16* Ho) {
  float s = 0.f;
#pragma unroll
  for (int i = 0; i < 16; ++i) s += v[i];
  s = wsum(s);
  const float mu = s * (1.f / 1024.f);
  float q = 0.f;
#pragma unroll
  for (int i = 0; i < 16; ++i) { const float d = v[i] - mu; q += d * d; }
  q = wsum(q);
  const float rstd = rsqrtf(q * (1.f / 1024.f) + 1e-5f);
#pragma unroll
  for (int half = 0; half < 2; ++half) {
    const int d0 = LAYOUT ? (lane * 16 + half * 8) : (half * 512 + lane * 8);
    float y[8];
#pragma unroll
    for (int i = 0; i < 8; ++i) y[i] = (v[half * 8 + i] - mu) * rstd * gam[d0 + i] + bet[d0 + i];
    *(float4*)(Xo + t * 1024 + d0) = make_float4(y[0], y[1], y[2], y[3]);
    *(float4*)(Xo + t * 1024 + d0 + 4) = make_float4(y[4], y[5], y[6], y[7]);
    if (Ho) {
      float hv[8];
#pragma unroll
      for (int i = 0; i < 8; ++i) hv[i] = y[i] * (1.f + sc[d0 + i]) + sh[d0 + i];
      *(uint4*)(Ho + t * 1024 + d0) = make_uint4(pk2(hv[0], hv[1]), pk2(hv[2], hv[3]), pk2(hv[4], hv[5]), pk2(hv[6], hv[7]));
    }
  }
}

DI void phase_ln1(const Params& P, int l) {
  const int tid_ = otid(); const int lane = tid_ & 63, w = tid_ >> 6;
  const float* R = (const float*)(P.ws + OFF_R);
  const float* MODS = (const float*)(P.ws + OFF_MODS);
  float* X = (float*)(P.ws + OFF_X);
  u16* H = (u16*)(P.ws + OFF_H);
  for (int t = blockIdx.x * 4 + w; t < T; t += gridDim.x * 4) {
    float v[16];
#pragma unroll
    for (int half = 0; half < 2; ++half) {
      const float4 a = *(const float4*)(R + (size_t)t * 1024 + half * 512 + lane * 8);
      const float4 c = *(const float4*)(R + (size_t)t * 1024 + half * 512 + lane * 8 + 4);
      v[half * 8 + 0] = a.x; v[half * 8 + 1] = a.y; v[half * 8 + 2] = a.z; v[half * 8 + 3] = a.w;
      v[half * 8 + 4] = c.x; v[half * 8 + 5] = c.y; v[half * 8 + 6] = c.z; v[half * 8 + 7] = c.w;
    }
    const int b = t >> 12;
    const float* md = MODS + (size_t)(l * 4 + b) * 6144;
    ln_finish<0>(v, (size_t)t, lane, P.ln_g + (size_t)(l * 2 + 0) * 1024, P.ln_b + (size_t)(l * 2 + 0) * 1024, md + 3072,
              md + 4096, X, H);
  }
}

DI void phase_gemm4(const Params& P, int l, char* smraw) {
  const u16* H = (const u16*)(P.ws + OFF_H);
  const u16* WQ = (const u16*)(P.ws + OFF_WQ) + (size_t)l * 1024 * 1024;
  u16* PQ = (u16*)(P.ws + OFF_PQ);
  GEMM_TILE_LOOP(4) {
    int nt, mt;
    gemm_tile(q, 4, mt, nt);
    const int m0 = mt * 128, n0 = nt * 256;
    f32x16 acc[2][4];
    ACC_ZERO(acc)
    gemm_main(H, 1024, WQ, 1024, 1024, m0, n0, acc, (u16*)smraw);
    EPI_IDS
    EPI_ROWS {
      const int row = m0 + wm * 64 + 32 * i + crow(e, h), col = n0 + wn * 128 + 4 * r;
      uint2 pk;
      pk.x = pk2(acc[i][0][e], acc[i][1][e]);
      pk.y = pk2(acc[i][2][e], acc[i][3][e]);
      *(uint2*)(PQ + (size_t)row * 1024 + col) = pk;
    }
  }
}

DI unsigned sortkey(float f, unsigned lowmask, unsigned lowval) {
  unsigned b = __float_as_uint(f);
  b = (b & 0x80000000u) ? ~b : (b | 0x80000000u);
  return (b & ~lowmask) | lowval;
}
DI float unsortkey(unsigned k, unsigned lowmask) {
  const unsigned b = k & ~lowmask;
  return __uint_as_float((b & 0x80000000u) ? (b & 0x7fffffffu) : ~b);
}
DI float sel4f(int g, float a, float b, float c, float d) { return g == 0 ? a : (g == 1 ? b : (g == 2 ? c : d)); }
DI int sel4i(int g, int a, int b, int c, int d) { return g == 0 ? a : (g == 1 ? b : (g == 2 ? c : d)); }

DI unsigned umin_(unsigned a, unsigned b) { return a < b ? a : b; }
DI void sort32_top16(unsigned (&v)[32]) {
  { const unsigned a_ = v[0], b_ = v[1]; v[0] = umax_(a_, b_); v[1] = umin_(a_, b_); }
  { const unsigned a_ = v[2], b_ = v[3]; v[2] = umin_(a_, b_); v[3] = umax_(a_, b_); }
  { const unsigned a_ = v[4], b_ = v[5]; v[4] = umax_(a_, b_); v[5] = umin_(a_, b_); }
  { const unsigned a_ = v[6], b_ = v[7]; v[6] = umin_(a_, b_); v[7] = umax_(a_, b_); }
  { const unsigned a_ = v[8], b_ = v[9]; v[8] = umax_(a_, b_); v[9] = umin_(a_, b_); }
  { const unsigned a_ = v[10], b_ = v[11]; v[10] = umin_(a_, b_); v[11] = umax_(a_, b_); }
  { const unsigned a_ = v[12], b_ = v[13]; v[12] = umax_(a_, b_); v[13] = umin_(a_, b_); }
  { const unsigned a_ = v[14], b_ = v[15]; v[14] = umin_(a_, b_); v[15] = umax_(a_, b_); }
  { const unsigned a_ = v[16], b_ = v[17]; v[16] = umax_(a_, b_); v[17] = umin_(a_, b_); }
  { const unsigned a_ = v[18], b_ = v[19]; v[18] = umin_(a_, b_); v[19] = umax_(a_, b_); }
  { const unsigned a_ = v[20], b_ = v[21]; v[20] = umax_(a_, b_); v[21] = umin_(a_, b_); }
  { const unsigned a_ = v[22], b_ = v[23]; v[22] = umin_(a_, b_); v[23] = umax_(a_, b_); }
  { const unsigned a_ = v[24], b_ = v[25]; v[24] = umax_(a_, b_); v[25] = umin_(a_, b_); }
  { const unsigned a_ = v[26], b_ = v[27]; v[26] = umin_(a_, b_); v[27] = umax_(a_, b_); }
  { const unsigned a_ = v[28], b_ = v[29]; v[28] = umax_(a_, b_); v[29] = umin_(a_, b_); }
  { const unsigned a_ = v[30], b_ = v[31]; v[30] = umin_(a_, b_); v[31] = umax_(a_, b_); }
  { const unsigned a_ = v[0], b_ = v[2]; v[0] = umax_(a_, b_); v[2] = umin_(a_, b_); }
  { const unsigned a_ = v[1], b_ = v[3]; v[1] = umax_(a_, b_); v[3] = umin_(a_, b_); }
  { const unsigned a_ = v[4], b_ = v[6]; v[4] = umin_(a_, b_); v[6] = umax_(a_, b_); }
  { const unsigned a_ = v[5], b_ = v[7]; v[5] = umin_(a_, b_); v[7] = umax_(a_, b_); }
  { const unsigned a_ = v[8], b_ = v[10]; v[8] = umax_(a_, b_); v[10] = umin_(a_, b_); }
  { const unsigned a_ = v[9], b_ = v[11]; v[9] = umax_(a_, b_); v[11] = umin_(a_, b_); }
  { const unsigned a_ = v[12], b_ = v[14]; v[12] = umin_(a_, b_); v[14] = umax_(a_, b_); }
  { const unsigned a_ = v[13], b_ = v[15]; v[13] = umin_(a_, b_); v[15] = umax_(a_, b_); }
  { const unsigned a_ = v[16], b_ = v[18]; v[16] = umax_(a_, b_); v[18] = umin_(a_, b_); }
  { const unsigned a_ = v[17], b_ = v[19]; v[17] = umax_(a_, b_); v[19] = umin_(a_, b_); }
  { const unsigned a_ = v[20], b_ = v[22]; v[20] = umin_(a_, b_); v[22] = umax_(a_, b_); }
  { const unsigned a_ = v[21], b_ = v[23]; v[21] = umin_(a_, b_); v[23] = umax_(a_, b_); }
  { const unsigned a_ = v[24], b_ = v[26]; v[24] = umax_(a_, b_); v[26] = umin_(a_, b_); }
  { const unsigned a_ = v[25], b_ = v[27]; v[25] = umax_(a_, b_); v[27] = umin_(a_, b_); }
  { const unsigned a_ = v[28], b_ = v[30]; v[28] = umin_(a_, b_); v[30] = umax_(a_, b_); }
  { const unsigned a_ = v[29], b_ = v[31]; v[29] = umin_(a_, b_); v[31] = umax_(a_, b_); }
  { const unsigned a_ = v[0], b_ = v[1]; v[0] = umax_(a_, b_); v[1] = umin_(a_, b_); }
  { const unsigned a_ = v[2], b_ = v[3]; v[2] = umax_(a_, b_); v[3] = umin_(a_, b_); }
  { const unsigned a_ = v[4], b_ = v[5]; v[4] = umin_(a_, b_); v[5] = umax_(a_, b_); }
  { const unsigned a_ = v[6], b_ = v[7]; v[6] = umin_(a_, b_); v[7] = umax_(a_, b_); }
  { const unsigned a_ = v[8], b_ = v[9]; v[8] = umax_(a_, b_); v[9] = umin_(a_, b_); }
  { const unsigned a_ = v[10], b_ = v[11]; v[10] = umax_(a_, b_); v[11] = umin_(a_, b_); }
  { const unsigned a_ = v[12], b_ = v[13]; v[12] = umin_(a_, b_); v[13] = umax_(a_, b_); }
  { const unsigned a_ = v[14], b_ = v[15]; v[14] = umin_(a_, b_); v[15] = umax_(a_, b_); }
  { const unsigned a_ = v[16], b_ = v[17]; v[16] = umax_(a_, b_); v[17] = umin_(a_, b_); }
  { const unsigned a_ = v[18], b_ = v[19]; v[18] = umax_(a_, b_); v[19] = umin_(a_, b_); }
  { const unsigned a_ = v[20], b_ = v[21]; v[20] = umin_(a_, b_); v[21] = umax_(a_, b_); }
  { const unsigned a_ = v[22], b_ = v[23]; v[22] = umin_(a_, b_); v[23] = umax_(a_, b_); }
  { const unsigned a_ = v[24], b_ = v[25]; v[24] = umax_(a_, b_); v[25] = umin_(a_, b_); }
  { const unsigned a_ = v[26], b_ = v[27]; v[26] = umax_(a_, b_); v[27] = umin_(a_, b_); }
  { const unsigned a_ = v[28], b_ = v[29]; v[28] = umin_(a_, b_); v[29] = umax_(a_, b_); }
  { const unsigned a_ = v[30], b_ = v[31]; v[30] = umin_(a_, b_); v[31] = umax_(a_, b_); }
  { const unsigned a_ = v[0], b_ = v[4]; v[0] = umax_(a_, b_); v[4] = umin_(a_, b_); }
  { const unsigned a_ = v[1], b_ = v[5]; v[1] = umax_(a_, b_); v[5] = umin_(a_, b_); }
  { const unsigned a_ = v[2], b_ = v[6]; v[2] = umax_(a_, b_); v[6] = umin_(a_, b_); }
  { const unsigned a_ = v[3], b_ = v[7]; v[3] = umax_(a_, b_); v[7] = umin_(a_, b_); }
  { const unsigned a_ = v[8], b_ = v[12]; v[8] = umin_(a_, b_); v[12] = umax_(a_, b_); }
  { const unsigned a_ = v[9], b_ = v[13]; v[9] = umin_(a_, b_); v[13] = umax_(a_, b_); }
  { const unsigned a_ = v[10], b_ = v[14]; v[10] = umin_(a_, b_); v[14] = umax_(a_, b_); }
  { const unsigned a_ = v[11], b_ = v[15]; v[11] = umin_(a_, b_); v[15] = umax_(a_, b_); }
  { const unsigned a_ = v[16], b_ = v[20]; v[16] = umax_(a_, b_); v[20] = umin_(a_, b_); }
  { const unsigned a_ = v[17], b_ = v[21]; v[17] = umax_(a_, b_); v[21] = umin_(a_, b_); }
  { const unsigned a_ = v[18], b_ = v[22]; v[18] = umax_(a_, b_); v[22] = umin_(a_, b_); }
  { const unsigned a_ = v[19], b_ = v[23]; v[19] = umax_(a_, b_); v[23] = umin_(a_, b_); }
  { const unsigned a_ = v[24], b_ = v[28]; v[24] = umin_(a_, b_); v[28] = umax_(a_, b_); }
  { const unsigned a_ = v[25], b_ = v[29]; v[25] = umin_(a_, b_); v[29] = umax_(a_, b_); }
  { const unsigned a_ = v[26], b_ = v[30]; v[26] = umin_(a_, b_); v[30] = umax_(a_, b_); }
  { const unsigned a_ = v[27], b_ = v[31]; v[27] = umin_(a_, b_); v[31] = umax_(a_, b_); }
  { const unsigned a_ = v[0], b_ = v[2]; v[0] = umax_(a_, b_); v[2] = umin_(a_, b_); }
  { const unsigned a_ = v[1], b_ = v[3]; v[1] = umax_(a_, b_); v[3] = umin_(a_, b_); }
  { const unsigned a_ = v[4], b_ = v[6]; v[4] = umax_(a_, b_); v[6] = umin_(a_, b_); }
  { const unsigned a_ = v[5], b_ = v[7]; v[5] = umax_(a_, b_); v[7] = umin_(a_, b_); }
  { const unsigned a_ = v[8], b_ = v[10]; v[8] = umin_(a_, b_); v[10] = umax_(a_, b_); }
  { const unsigned a_ = v[9], b_ = v[11]; v[9] = umin_(a_, b_); v[11] = umax_(a_, b_); }
  { const unsigned a_ = v[12], b_ = v[14]; v[12] = umin_(a_, b_); v[14] = umax_(a_, b_); }
  { const unsigned a_ = v[13], b_ = v[15]; v[13] = umin_(a_, b_); v[15] = umax_(a_, b_); }
  { const unsigned a_ = v[16], b_ = v[18]; v[16] = umax_(a_, b_); v[18] = umin_(a_, b_); }
  { const unsigned a_ = v[17], b_ = v[19]; v[17] = umax_(a_, b_); v[19] = umin_(a_, b_); }
  { const unsigned a_ = v[20], b_ = v[22]; v[20] = umax_(a_, b_); v[22] = umin_(a_, b_); }
  { const unsigned a_ = v[21], b_ = v[23]; v[21] = umax_(a_, b_); v[23] = umin_(a_, b_); }
  { const unsigned a_ = v[24], b_ = v[26]; v[24] = umin_(a_, b_); v[26] = umax_(a_, b_); }
  { const unsigned a_ = v[25], b_ = v[27]; v[25] = umin_(a_, b_); v[27] = umax_(a_, b_); }
  { const unsigned a_ = v[28], b_ = v[30]; v[28] = umin_(a_, b_); v[30] = umax_(a_, b_); }
  { const unsigned a_ = v[29], b_ = v[31]; v[29] = umin_(a_, b_); v[31] = umax_(a_, b_); }
  { const unsigned a_ = v[0], b_ = v[1]; v[0] = umax_(a_, b_); v[1] = umin_(a_, b_); }
  { const unsigned a_ = v[2], b_ = v[3]; v[2] = umax_(a_, b_); v[3] = umin_(a_, b_); }
  { const unsigned a_ = v[4], b_ = v[5]; v[4] = umax_(a_, b_); v[5] = umin_(a_, b_); }
  { const unsigned a_ = v[6], b_ = v[7]; v[6] = umax_(a_, b_); v[7] = umin_(a_, b_); }
  { const unsigned a_ = v[8], b_ = v[9]; v[8] = umin_(a_, b_); v[9] = umax_(a_, b_); }
  { const unsigned a_ = v[10], b_ = v[11]; v[10] = umin_(a_, b_); v[11] = umax_(a_, b_); }
  { const unsigned a_ = v[12], b_ = v[13]; v[12] = umin_(a_, b_); v[13] = umax_(a_, b_); }
  { const unsigned a_ = v[14], b_ = v[15]; v[14] = umin_(a_, b_); v[15] = umax_(a_, b_); }
  { const unsigned a_ = v[16], b_ = v[17]; v[16] = umax_(a_, b_); v[17] = umin_(a_, b_); }
  { const unsigned a_ = v[18], b_ = v[19]; v[18] = umax_(a_, b_); v[19] = umin_(a_, b_); }
  { const unsigned a_ = v[20], b_ = v[21]; v[20] = umax_(a_, b_); v[21] = umin_(a_, b_); }
  { const unsigned a_ = v[22], b_ = v[23]; v[22] = umax_(a_, b_); v[23] = umin_(a_, b_); }
  { const unsigned a_ = v[24], b_ = v[25]; v[24] = umin_(a_, b_); v[25] = umax_(a_, b_); }
  { const unsigned a_ = v[26], b_ = v[27]; v[26] = umin_(a_, b_); v[27] = umax_(a_, b_); }
  { const unsigned a_ = v[28], b_ = v[29]; v[28] = umin_(a_, b_); v[29] = umax_(a_, b_); }
  { const unsigned a_ = v[30], b_ = v[31]; v[30] = umin_(a_, b_); v[31] = umax_(a_, b_); }
  { const unsigned a_ = v[0], b_ = v[8]; v[0] = umax_(a_, b_); v[8] = umin_(a_, b_); }
  { const unsigned a_ = v[1], b_ = v[9]; v[1] = umax_(a_, b_); v[9] = umin_(a_, b_); }
  { const unsigned a_ = v[2], b_ = v[10]; v[2] = umax_(a_, b_); v[10] = umin_(a_, b_); }
  { const unsigned a_ = v[3], b_ = v[11]; v[3] = umax_(a_, b_); v[11] = umin_(a_, b_); }
  { const unsigned a_ = v[4], b_ = v[12]; v[4] = umax_(a_, b_); v[12] = umin_(a_, b_); }
  { const unsigned a_ = v[5], b_ = v[13]; v[5] = umax_(a_, b_); v[13] = umin_(a_, b_); }
  { const unsigned a_ = v[6], b_ = v[14]; v[6] = umax_(a_, b_); v[14] = umin_(a_, b_); }
  { const unsigned a_ = v[7], b_ = v[15]; v[7] = umax_(a_, b_); v[15] = umin_(a_, b_); }
  { const unsigned a_ = v[16], b_ = v[24]; v[16] = umin_(a_, b_); v[24] = umax_(a_, b_); }
  { const unsigned a_ = v[17], b_ = v[25]; v[17] = umin_(a_, b_); v[25] = umax_(a_, b_); }
  { const unsigned a_ = v[18], b_ = v[26]; v[18] = umin_(a_, b_); v[26] = umax_(a_, b_); }
  { const unsigned a_ = v[19], b_ = v[27]; v[19] = umin_(a_, b_); v[27] = umax_(a_, b_); }
  { const unsigned a_ = v[20], b_ = v[28]; v[20] = umin_(a_, b_); v[28] = umax_(a_, b_); }
  { const unsigned a_ = v[21], b_ = v[29]; v[21] = umin_(a_, b_); v[29] = umax_(a_, b_); }
  { const unsigned a_ = v[22], b_ = v[30]; v[22] = umin_(a_, b_); v[30] = umax_(a_, b_); }
  { const unsigned a_ = v[23], b_ = v[31]; v[23] = umin_(a_, b_); v[31] = umax_(a_, b_); }
  { const unsigned a_ = v[0], b_ = v[4]; v[0] = umax_(a_, b_); v[4] = umin_(a_, b_); }
  { const unsigned a_ = v[1], b_ = v[5]; v[1] = umax_(a_, b_); v[5] = umin_(a_, b_); }
  { const unsigned a_ = v[2], b_ = v[6]; v[2] = umax_(a_, b_); v[6] = umin_(a_, b_); }
  { const unsigned a_ = v[3], b_ = v[7]; v[3] = umax_(a_, b_); v[7] = umin_(a_, b_); }
  { const unsigned a_ = v[8], b_ = v[12]; v[8] = umax_(a_, b_); v[12] = umin_(a_, b_); }
  { const unsigned a_ = v[9], b_ = v[13]; v[9] = umax_(a_, b_); v[13] = umin_(a_, b_); }
  { const unsigned a_ = v[10], b_ = v[14]; v[10] = umax_(a_, b_); v[14] = umin_(a_, b_); }
  { const unsigned a_ = v[11], b_ = v[15]; v[11] = umax_(a_, b_); v[15] = umin_(a_, b_); }
  { const unsigned a_ = v[16], b_ = v[20]; v[16] = umin_(a_, b_); v[20] = umax_(a_, b_); }
  { const unsigned a_ = v[17], b_ = v[21]; v[17] = umin_(a_, b_); v[21] = umax_(a_, b_); }
  { const unsigned a_ = v[18], b_ = v[22]; v[18] = umin_(a_, b_); v[22] = umax_(a_, b_); }
  { const unsigned a_ = v[19], b_ = v[23]; v[19] = umin_(a_, b_); v[23] = umax_(a_, b_); }
  { const unsigned a_ = v[24], b_ = v[28]; v[24] = umin_(a_, b_); v[28] = umax_(a_, b_); }
  { const unsigned a_ = v[25], b_ = v[29]; v[25] = umin_(a_, b_); v[29] = umax_(a_, b_); }
  { const unsigned a_ = v[26], b_ = v[30]; v[26] = umin_(a_, b_); v[30] = umax_(a_, b_); }
  { const unsigned a_ = v[27], b_ = v[31]; v[27] = umin_(a_, b_); v[31] = umax_(a_, b_); }
  { const unsigned a_ = v[0], b_ = v[2]; v[0] = umax_(a_, b_); v[2] = umin_(a_, b_); }
  { const unsigned a_ = v[1], b_ = v[3]; v[1] = umax_(a_, b_); v[3] = umin_(a_, b_); }
  { const unsigned a_ = v[4], b_ = v[6]; v[4] = umax_(a_, b_); v[6] = umin_(a_, b_); }
  { const unsigned a_ = v[5], b_ = v[7]; v[5] = umax_(a_, b_); v[7] = umin_(a_, b_); }
  { const unsigned a_ = v[8], b_ = v[10]; v[8] = umax_(a_, b_); v[10] = umin_(a_, b_); }
  { const unsigned a_ = v[9], b_ = v[11]; v[9] = umax_(a_, b_); v[11] = umin_(a_, b_); }
  { const unsigned a_ = v[12], b_ = v[14]; v[12] = umax_(a_, b_); v[14] = umin_(a_, b_); }
  { const unsigned a_ = v[13], b_ = v[15]; v[13] = umax_(a_, b_); v[15] = umin_(a_, b_); }
  { const unsigned a_ = v[16], b_ = v[18]; v[16] = umin_(a_, b_); v[18] = umax_(a_, b_); }
  { const unsigned a_ = v[17], b_ = v[19]; v[17] = umin_(a_, b_); v[19] = umax_(a_, b_); }
  { const unsigned a_ = v[20], b_ = v[22]; v[20] = umin_(a_, b_); v[22] = umax_(a_, b_); }
  { const unsigned a_ = v[21], b_ = v[23]; v[21] = umin_(a_, b_); v[23] = umax_(a_, b_); }
  { const unsigned a_ = v[24], b_ = v[26]; v[24] = umin_(a_, b_); v[26] = umax_(a_, b_); }
  { const unsigned a_ = v[25], b_ = v[27]; v[25] = umin_(a_, b_); v[27] = umax_(a_, b_); }
  { const unsigned a_ = v[28], b_ = v[30]; v[28] = umin_(a_, b_); v[30] = umax_(a_, b_); }
  { const unsigned a_ = v[29], b_ = v[31]; v[29] = umin_(a_, b_); v[31] = umax_(a_, b_); }
  { const unsigned a_ = v[0], b_ = v[1]; v[0] = umax_(a_, b_); v[1] = umin_(a_, b_); }
  { const unsigned a_ = v[2], b_ = v[3]; v[2] = umax_(a_, b_); v[3] = umin_(a_, b_); }
  { const unsigned a_ = v[4], b_ = v[5]; v[4] = umax_(a_, b_); v[5] = umin_(a_, b_); }
  { const unsigned a_ = v[6], b_ = v[7]; v[6] = umax_(a_, b_); v[7] = umin_(a_, b_); }
  { const unsigned a_ = v[8], b_ = v[9]; v[8] = umax_(a_, b_); v[9] = umin_(a_, b_); }
  { const unsigned a_ = v[10], b_ = v[11]; v[10] = umax_(a_, b_); v[11] = umin_(a_, b_); }
  { const unsigned a_ = v[12], b_ = v[13]; v[12] = umax_(a_, b_); v[13] = umin_(a_, b_); }
  { const unsigned a_ = v[14], b_ = v[15]; v[14] = umax_(a_, b_); v[15] = umin_(a_, b_); }
  { const unsigned a_ = v[16], b_ = v[17]; v[16] = umin_(a_, b_); v[17] = umax_(a_, b_); }
  { const unsigned a_ = v[18], b_ = v[19]; v[18] = umin_(a_, b_); v[19] = umax_(a_, b_); }
  { const unsigned a_ = v[20], b_ = v[21]; v[20] = umin_(a_, b_); v[21] = umax_(a_, b_); }
  { const unsigned a_ = v[22], b_ = v[23]; v[22] = umin_(a_, b_); v[23] = umax_(a_, b_); }
  { const unsigned a_ = v[24], b_ = v[25]; v[24] = umin_(a_, b_); v[25] = umax_(a_, b_); }
  { const unsigned a_ = v[26], b_ = v[27]; v[26] = umin_(a_, b_); v[27] = umax_(a_, b_); }
  { const unsigned a_ = v[28], b_ = v[29]; v[28] = umin_(a_, b_); v[29] = umax_(a_, b_); }
  { const unsigned a_ = v[30], b_ = v[31]; v[30] = umin_(a_, b_); v[31] = umax_(a_, b_); }
  v[0] = umax_(v[0], v[16]);
  v[1] = umax_(v[1], v[17]);
  v[2] = umax_(v[2], v[18]);
  v[3] = umax_(v[3], v[19]);
  v[4] = umax_(v[4], v[20]);
  v[5] = umax_(v[5], v[21]);
  v[6] = umax_(v[6], v[22]);
  v[7] = umax_(v[7], v[23]);
  v[8] = umax_(v[8], v[24]);
  v[9] = umax_(v[9], v[25]);
  v[10] = umax_(v[10], v[26]);
  v[11] = umax_(v[11], v[27]);
  v[12] = umax_(v[12], v[28]);
  v[13] = umax_(v[13], v[29]);
  v[14] = umax_(v[14], v[30]);
  v[15] = umax_(v[15], v[31]);
  { const unsigned a_ = v[0], b_ = v[8]; v[0] = umax_(a_, b_); v[8] = umin_(a_, b_); }
  { const unsigned a_ = v[1], b_ = v[9]; v[1] = umax_(a_, b_); v[9] = umin_(a_, b_); }
  { const unsigned a_ = v[2], b_ = v[10]; v[2] = umax_(a_, b_); v[10] = umin_(a_, b_); }
  { const unsigned a_ = v[3], b_ = v[11]; v[3] = umax_(a_, b_); v[11] = umin_(a_, b_); }
  { const unsigned a_ = v[4], b_ = v[12]; v[4] = umax_(a_, b_); v[12] = umin_(a_, b_); }
  { const unsigned a_ = v[5], b_ = v[13]; v[5] = umax_(a_, b_); v[13] = umin_(a_, b_); }
  { const unsigned a_ = v[6], b_ = v[14]; v[6] = umax_(a_, b_); v[14] = umin_(a_, b_); }
  { const unsigned a_ = v[7], b_ = v[15]; v[7] = umax_(a_, b_); v[15] = umin_(a_, b_); }
  { const unsigned a_ = v[0], b_ = v[4]; v[0] = umax_(a_, b_); v[4] = umin_(a_, b_); }
  { const unsigned a_ = v[1], b_ = v[5]; v[1] = umax_(a_, b_); v[5] = umin_(a_, b_); }
  { const unsigned a_ = v[2], b_ = v[6]; v[2] = umax_(a_, b_); v[6] = umin_(a_, b_); }
  { const unsigned a_ = v[3], b_ = v[7]; v[3] = umax_(a_, b_); v[7] = umin_(a_, b_); }
  { const unsigned a_ = v[8], b_ = v[12]; v[8] = umax_(a_, b_); v[12] = umin_(a_, b_); }
  { const unsigned a_ = v[9], b_ = v[13]; v[9] = umax_(a_, b_); v[13] = umin_(a_, b_); }
  { const unsigned a_ = v[10], b_ = v[14]; v[10] = umax_(a_, b_); v[14] = umin_(a_, b_); }
  { const unsigned a_ = v[11], b_ = v[15]; v[11] = umax_(a_, b_); v[15] = umin_(a_, b_); }
  { const unsigned a_ = v[0], b_ = v[2]; v[0] = umax_(a_, b_); v[2] = umin_(a_, b_); }
  { const unsigned a_ = v[1], b_ = v[3]; v[1] = umax_(a_, b_); v[3] = umin_(a_, b_); }
  { const unsigned a_ = v[4], b_ = v[6]; v[4] = umax_(a_, b_); v[6] = umin_(a_, b_); }
  { const unsigned a_ = v[5], b_ = v[7]; v[5] = umax_(a_, b_); v[7] = umin_(a_, b_); }
  { const unsigned a_ = v[8], b_ = v[10]; v[8] = umax_(a_, b_); v[10] = umin_(a_, b_); }
  { const unsigned a_ = v[9], b_ = v[11]; v[9] = umax_(a_, b_); v[11] = umin_(a_, b_); }
  { const unsigned a_ = v[12], b_ = v[14]; v[12] = umax_(a_, b_); v[14] = umin_(a_, b_); }
  { const unsigned a_ = v[13], b_ = v[15]; v[13] = umax_(a_, b_); v[15] = umin_(a_, b_); }
  { const unsigned a_ = v[0], b_ = v[1]; v[0] = umax_(a_, b_); v[1] = umin_(a_, b_); }
  { const unsigned a_ = v[2], b_ = v[3]; v[2] = umax_(a_, b_); v[3] = umin_(a_, b_); }
  { const unsigned a_ = v[4], b_ = v[5]; v[4] = umax_(a_, b_); v[5] = umin_(a_, b_); }
  { const unsigned a_ = v[6], b_ = v[7]; v[6] = umax_(a_, b_); v[7] = umin_(a_, b_); }
  { const unsigned a_ = v[8], b_ = v[9]; v[8] = umax_(a_, b_); v[9] = umin_(a_, b_); }
  { const unsigned a_ = v[10], b_ = v[11]; v[10] = umax_(a_, b_); v[11] = umin_(a_, b_); }
  { const unsigned a_ = v[12], b_ = v[13]; v[12] = umax_(a_, b_); v[13] = umin_(a_, b_); }
  { const unsigned a_ = v[14], b_ = v[15]; v[14] = umax_(a_, b_); v[15] = umin_(a_, b_); }
}
DI void merge16(unsigned (&v)[32], int m) {
  unsigned o[16];
  o[0] = shx(v[15], m);
  o[1] = shx(v[14], m);
  o[2] = shx(v[13], m);
  o[3] = shx(v[12], m);
  o[4] = shx(v[11], m);
  o[5] = shx(v[10], m);
  o[6] = shx(v[9], m);
  o[7] = shx(v[8], m);
  o[8] = shx(v[7], m);
  o[9] = shx(v[6], m);
  o[10] = shx(v[5], m);
  o[11] = shx(v[4], m);
  o[12] = shx(v[3], m);
  o[13] = shx(v[2], m);
  o[14] = shx(v[1], m);
  o[15] = shx(v[0], m);
  v[0] = umax_(v[0], o[0]);
  v[1] = umax_(v[1], o[1]);
  v[2] = umax_(v[2], o[2]);
  v[3] = umax_(v[3], o[3]);
  v[4] = umax_(v[4], o[4]);
  v[5] = umax_(v[5], o[5]);
  v[6] = umax_(v[6], o[6]);
  v[7] = umax_(v[7], o[7]);
  v[8] = umax_(v[8], o[8]);
  v[9] = umax_(v[9], o[9]);
  v[10] = umax_(v[10], o[10]);
  v[11] = umax_(v[11], o[11]);
  v[12] = umax_(v[12], o[12]);
  v[13] = umax_(v[13], o[13]);
  v[14] = umax_(v[14], o[14]);
  v[15] = umax_(v[15], o[15]);
  { const unsigned a_ = v[0], b_ = v[8]; v[0] = umax_(a_, b_); v[8] = umin_(a_, b_); }
  { const unsigned a_ = v[1], b_ = v[9]; v[1] = umax_(a_, b_); v[9] = umin_(a_, b_); }
  { const unsigned a_ = v[2], b_ = v[10]; v[2] = umax_(a_, b_); v[10] = umin_(a_, b_); }
  { const unsigned a_ = v[3], b_ = v[11]; v[3] = umax_(a_, b_); v[11] = umin_(a_, b_); }
  { const unsigned a_ = v[4], b_ = v[12]; v[4] = umax_(a_, b_); v[12] = umin_(a_, b_); }
  { const unsigned a_ = v[5], b_ = v[13]; v[5] = umax_(a_, b_); v[13] = umin_(a_, b_); }
  { const unsigned a_ = v[6], b_ = v[14]; v[6] = umax_(a_, b_); v[14] = umin_(a_, b_); }
  { const unsigned a_ = v[7], b_ = v[15]; v[7] = umax_(a_, b_); v[15] = umin_(a_, b_); }
  { const unsigned a_ = v[0], b_ = v[4]; v[0] = umax_(a_, b_); v[4] = umin_(a_, b_); }
  { const unsigned a_ = v[1], b_ = v[5]; v[1] = umax_(a_, b_); v[5] = umin_(a_, b_); }
  { const unsigned a_ = v[2], b_ = v[6]; v[2] = umax_(a_, b_); v[6] = umin_(a_, b_); }
  { const unsigned a_ = v[3], b_ = v[7]; v[3] = umax_(a_, b_); v[7] = umin_(a_, b_); }
  { const unsigned a_ = v[8], b_ = v[12]; v[8] = umax_(a_, b_); v[12] = umin_(a_, b_); }
  { const unsigned a_ = v[9], b_ = v[13]; v[9] = umax_(a_, b_); v[13] = umin_(a_, b_); }
  { const unsigned a_ = v[10], b_ = v[14]; v[10] = umax_(a_, b_); v[14] = umin_(a_, b_); }
  { const unsigned a_ = v[11], b_ = v[15]; v[11] = umax_(a_, b_); v[15] = umin_(a_, b_); }
  { const unsigned a_ = v[0], b_ = v[2]; v[0] = umax_(a_, b_); v[2] = umin_(a_, b_); }
  { const unsigned a_ = v[1], b_ = v[3]; v[1] = umax_(a_, b_); v[3] = umin_(a_, b_); }
  { const unsigned a_ = v[4], b_ = v[6]; v[4] = umax_(a_, b_); v[6] = umin_(a_, b_); }
  { const unsigned a_ = v[5], b_ = v[7]; v[5] = umax_(a_, b_); v[7] = umin_(a_, b_); }
  { const unsigned a_ = v[8], b_ = v[10]; v[8] = umax_(a_, b_); v[10] = umin_(a_, b_); }
  { const unsigned a_ = v[9], b_ = v[11]; v[9] = umax_(a_, b_); v[11] = umin_(a_, b_); }
  { const unsigned a_ = v[12], b_ = v[14]; v[12] = umax_(a_, b_); v[14] = umin_(a_, b_); }
  { const unsigned a_ = v[13], b_ = v[15]; v[13] = umax_(a_, b_); v[15] = umin_(a_, b_); }
  { const unsigned a_ = v[0], b_ = v[1]; v[0] = umax_(a_, b_); v[1] = umin_(a_, b_); }
  { const unsigned a_ = v[2], b_ = v[3]; v[2] = umax_(a_, b_); v[3] = umin_(a_, b_); }
  { const unsigned a_ = v[4], b_ = v[5]; v[4] = umax_(a_, b_); v[5] = umin_(a_, b_); }
  { const unsigned a_ = v[6], b_ = v[7]; v[6] = umax_(a_, b_); v[7] = umin_(a_, b_); }
  { const unsigned a_ = v[8], b_ = v[9]; v[8] = umax_(a_, b_); v[9] = umin_(a_, b_); }
  { const unsigned a_ = v[10], b_ = v[11]; v[10] = umax_(a_, b_); v[11] = umin_(a_, b_); }
  { const unsigned a_ = v[12], b_ = v[13]; v[12] = umax_(a_, b_); v[13] = umin_(a_, b_); }
  { const unsigned a_ = v[14], b_ = v[15]; v[14] = umax_(a_, b_); v[15] = umin_(a_, b_); }
}

DI void phase_route(const Params& P, int l) {
  const int tid_ = otid(); const int lane = tid_ & 63, w = tid_ >> 6;
  const u16* PQ = (const u16*)(P.ws + OFF_PQ);
  const u16* KEYS = (const u16*)(P.ws + OFF_KEYS);
  int* EIDX = (int*)(P.ws + OFF_EIDX);
  float* EG = (float*)(P.ws + OFF_EG);
  const int n = lane & 15, g4 = lane >> 4;
  for (int item = blockIdx.x * 4 + w; item < 1024 * 8; item += gridDim.x * 4) {
    const int hh = item & 7, t0 = (item >> 3) * 16;
    const u16* pq = PQ + (size_t)(t0 + n) * 1024 + hh * 128;
    unsigned v[2][32];
#pragma unroll
    for (int p = 0; p < 2; ++p) {
      const bf16x8 q0 = *(const bf16x8*)(pq + p * 64 + 8 * g4);
      const bf16x8 q1 = *(const bf16x8*)(pq + p * 64 + 32 + 8 * g4);
      const u16* kb = KEYS + (size_t)(((l * 8 + hh) * 2 + p) * 128) * 64;
#pragma unroll
      for (int mt = 0; mt < 8; ++mt) {
        const bf16x8 a0 = *(const bf16x8*)(kb + (size_t)(mt * 16 + n) * 64 + 8 * g4);
        const bf16x8 a1 = *(const bf16x8*)(kb + (size_t)(mt * 16 + n) * 64 + 32 + 8 * g4);
        f32x4 d = {0.f, 0.f, 0.f, 0.f};
        d = MFMA16(a0, q0, d);
        d = MFMA16(a1, q1, d);
#pragma unroll
        for (int i = 0; i < 4; ++i) v[p][mt * 4 + i] = sortkey(d[i], 0x7Fu, (unsigned)(127 - (mt * 16 + 4 * g4 + i)));
      }
    }
    float s1v[16], s2v[16];
    int i1[16], i2[16];
#pragma unroll
    for (int p = 0; p < 2; ++p) {
      sort32_top16(v[p]);
      merge16(v[p], 16);
      merge16(v[p], 32);
    }
#pragma unroll
    for (int it = 0; it < 16; ++it) {
      s1v[it] = unsortkey(v[0][it], 0x7Fu);
      i1[it] = 127 - (int)(v[0][it] & 0x7Fu);
      s2v[it] = unsortkey(v[1][it], 0x7Fu);
      i2[it] = 127 - (int)(v[1][it] & 0x7Fu);
    }
    float sa[4];
    int ia[4];
#pragma unroll
    for (int q = 0; q < 4; ++q) {
      sa[q] = sel4f(g4, s1v[4 * q], s1v[4 * q + 1], s1v[4 * q + 2], s1v[4 * q + 3]);
      ia[q] = sel4i(g4, i1[4 * q], i1[4 * q + 1], i1[4 * q + 2], i1[4 * q + 3]);
    }
    unsigned cand[21];
    int ce[21];
#pragma unroll
    for (int bb = 0; bb < 16; ++bb) {
      const bool ok = (g4 + 1) * (bb + 1) <= 16;
      cand[bb] = ok ? sortkey(sa[0] + s2v[bb], 0xFFu, (unsigned)(255 - (g4 * 16 + bb))) : 0u;
      ce[bb] = ia[0] * 128 + i2[bb];
    }
#pragma unroll
    for (int bb = 0; bb < 3; ++bb) {
      const bool ok = (5 + g4) * (bb + 1) <= 16;
      cand[16 + bb] = ok ? sortkey(sa[1] + s2v[bb], 0xFFu, (unsigned)(255 - ((4 + g4) * 16 + bb))) : 0u;
      ce[16 + bb] = ia[1] * 128 + i2[bb];
    }
    cand[19] = sortkey(sa[2] + s2v[0], 0xFFu, (unsigned)(255 - ((8 + g4) * 16)));
    ce[19] = ia[2] * 128 + i2[0];
    cand[20] = sortkey(sa[3] + s2v[0], 0xFFu, (unsigned)(255 - ((12 + g4) * 16)));
    ce[20] = ia[3] * 128 + i2[0];
    float sv[16];
    int* eo = EIDX + (size_t)(t0 + n) * 128 + hh * 16;
#pragma unroll
    for (int it = 0; it < 16; ++it) {
      unsigned mx = 0u;
#pragma unroll
      for (int j = 0; j < 21; ++j) mx = umax_(mx, cand[j]);
      mx = umax_(mx, shx(mx, 16));
      mx = umax_(mx, shx(mx, 32));
      sv[it] = unsortkey(mx, 0xFFu);
      int e = -1;
#pragma unroll
      for (int j = 0; j < 21; ++j) {
        const bool eq = (cand[j] == mx);
        e = eq ? ce[j] : e;
        cand[j] = eq ? 0u : cand[j];
      }
      if (e >= 0) eo[it] = e;
    }
    const float top = sv[0];
    float den = 0.f;
#pragma unroll
    for (int it = 0; it < 16; ++it) { sv[it] = __expf(sv[it] - top); den += sv[it]; }
    const float rden = 1.f / den;
    if (g4 == 0) {
      float* go = EG + (size_t)(t0 + n) * 128 + hh * 16;
#pragma unroll
      for (int q = 0; q < 4; ++q)
        *(float4*)(go + 4 * q) = make_float4(sv[4 * q] * rden, sv[4 * q + 1] * rden, sv[4 * q + 2] * rden, sv[4 * q + 3] * rden);
    }
  }
}

template <int B> DI f32x2 unp4(unsigned w) { return __builtin_amdgcn_cvt_scalef32_pk_f32_fp4(w, 1.0f, B); }
DI void cvt16(const u32x4& a, float (&f)[16]) {
#pragma unroll
  for (int q = 0; q < 4; ++q) {
    const f32x2 lo = __builtin_amdgcn_cvt_pk_f32_fp8(a[q], false);
    const f32x2 hi = __builtin_amdgcn_cvt_pk_f32_fp8(a[q], true);
    f[4 * q] = lo.x; f[4 * q + 1] = lo.y; f[4 * q + 2] = hi.x; f[4 * q + 3] = hi.y;
  }
}

DI void phase_gather(const Params& P, int l) {
  const int tid_ = otid(); const int lane = tid_ & 63, w = tid_ >> 6;
  const u16* H = (const u16*)(P.ws + OFF_H);
  const int* EIDX = (const int*)(P.ws + OFF_EIDX);
  const float* EG = (const float*)(P.ws + OFF_EG);
  const unsigned char* U = (const unsigned char*)(P.ws + OFF_U) + (size_t)l * 16384 * 512;
  const unsigned char* V = (const unsigned char*)(P.ws + OFF_V) + (size_t)l * 16384 * 512;
  const float* USC = (const float*)(P.ws + OFF_USC) + (size_t)l * 16384;
  const float* VSC = (const float*)(P.ws + OFF_VSC) + (size_t)l * 16384;
  const float* MODS = (const float*)(P.ws + OFF_MODS);
  float* X = (float*)(P.ws + OFF_X);
  u16* Hn = (u16*)(P.ws + OFF_H);
  for (int t = blockIdx.x * 4 + w; t < T; t += gridDim.x * 4) {
    float acc[16];
#pragma unroll
    for (int i = 0; i < 16; ++i) acc[i] = 0.f;
#if DO_PEER
    f32x2 hf2[8];
    {
      const u32x4 h0 = *(const u32x4*)(H + (size_t)t * 1024 + lane * 16);
      const u32x4 h1 = *(const u32x4*)(H + (size_t)t * 1024 + lane * 16 + 8);
#pragma unroll
      for (int q = 0; q < 4; ++q) {
        hf2[q] = (f32x2){bflo(h0[q]), bfhi(h0[q])};
        hf2[4 + q] = (f32x2){bflo(h1[q]), bfhi(h1[q])};
      }
    }
    const int e0 = EIDX[(size_t)t * 128 + lane], e1 = EIDX[(size_t)t * 128 + 64 + lane];
    const float g0 = EG[(size_t)t * 128 + lane] * VSC[e0], g1 = EG[(size_t)t * 128 + 64 + lane] * VSC[e1];
    const float su0 = USC[e0], su1 = USC[e1];
    float w0 = 0.f, w1 = 0.f;
    f32x2 acc2[8];
#pragma unroll 1
    for (int rep = 0; rep < REP_GATHER; ++rep) {
#pragma unroll
    for (int i = 0; i < 8; ++i) acc2[i] = (f32x2){0.f, 0.f};
    u32x2 bufA[32], bufB[32];
#define G_LOAD(BUF, TAB, C)                                                                   \
  _Pragma("unroll") for (int j = 0; j < 32; ++j) {                                            \
    const int idx_ = __builtin_amdgcn_readlane(((C) < 2) ? e0 : e1, (((C) & 1) << 5) + j);    \
    BUF[j] = *(const u32x2*)(TAB + (size_t)idx_ * 512 + lane * 8);                            \
  }
#define G_UCOMP(BUF, C)                                                                       \
  {                                                                                           \
    float p[32];                                                                              \
    _Pragma("unroll") for (int j = 0; j < 32; ++j) {                                          \
      f32x2 a2 = {0.f, 0.f};                                                                  \
      _Pragma("unroll") for (int d = 0; d < 2; ++d) {                                         \
        a2 = __builtin_elementwise_fma(unp4<0>(BUF[j][d]), hf2[4 * d + 0], a2);               \
        a2 = __builtin_elementwise_fma(unp4<1>(BUF[j][d]), hf2[4 * d + 1], a2);               \
        a2 = __builtin_elementwise_fma(unp4<2>(BUF[j][d]), hf2[4 * d + 2], a2);               \
        a2 = __builtin_elementwise_fma(unp4<3>(BUF[j][d]), hf2[4 * d + 3], a2);               \
      }                                                                                       \
      p[j] = a2.x + a2.y;                                                                     \
    }                                                                                         \
    float q1 = xsum32(p, lane);                                                               \
    q1 += __shfl_xor(q1, 32);                                                                 \
    const bool mine = (lane >> 5) == ((C) & 1);                                               \
    if ((C) < 2) w0 = mine ? gelu_tanh(q1 * su0) * g0 : w0;                                   \
    else w1 = mine ? gelu_tanh(q1 * su1) * g1 : w1;                                           \
  }
#define G_VCOMP(BUF, C)                                                                       \
  {                                                                                           \
    const float wv_ = ((C) < 2) ? w0 : w1;                                                    \
    _Pragma("unroll") for (int j = 0; j < 32; ++j) {                                          \
      const float wj = __int_as_float(__builtin_amdgcn_readlane(__float_as_int(wv_), (((C) & 1) << 5) + j)); \
      const f32x2 wv2 = {wj, wj};                                                             \
      _Pragma("unroll") for (int d = 0; d < 2; ++d) {                                         \
        acc2[4 * d + 0] = __builtin_elementwise_fma(wv2, unp4<0>(BUF[j][d]), acc2[4 * d + 0]); \
        acc2[4 * d + 1] = __builtin_elementwise_fma(wv2, unp4<1>(BUF[j][d]), acc2[4 * d + 1]); \
        acc2[4 * d + 2] = __builtin_elementwise_fma(wv2, unp4<2>(BUF[j][d]), acc2[4 * d + 2]); \
        acc2[4 * d + 3] = __builtin_elementwise_fma(wv2, unp4<3>(BUF[j][d]), acc2[4 * d + 3]); \
      }                                                                                       \
    }                                                                                         \
  }
#define G_SB __builtin_amdgcn_sched_barrier(0);
    G_LOAD(bufA, U, 0) G_SB
    G_LOAD(bufB, U, 1) G_SB  G_UCOMP(bufA, 0) G_SB
    G_LOAD(bufA, U, 2) G_SB  G_UCOMP(bufB, 1) G_SB
    G_LOAD(bufB, U, 3) G_SB  G_UCOMP(bufA, 2) G_SB
    G_LOAD(bufA, V, 0) G_SB  G_UCOMP(bufB, 3) G_SB
    G_LOAD(bufB, V, 1) G_SB  G_VCOMP(bufA, 0) G_SB
    G_LOAD(bufA, V, 2) G_SB  G_VCOMP(bufB, 1) G_SB
    G_LOAD(bufB, V, 3) G_SB  G_VCOMP(bufA, 2) G_SB
    G_VCOMP(bufB, 3)
#undef G_LOAD
#undef G_UCOMP
#undef G_VCOMP
#undef G_SB
    asm volatile("" : "+v"(w0), "+v"(w1));
    }
#pragma unroll
    for (int i = 0; i < 8; ++i) { acc[2 * i] = acc2[i].x; acc[2 * i + 1] = acc2[i].y; }
#endif
    const int b = t >> 12;
    const float* md = MODS + (size_t)(l * 4 + b) * 6144;
    float v[16];
#pragma unroll
    for (int half = 0; half < 2; ++half) {
      const int d0 = lane * 16 + half * 8;
      const float4 xa = *(const float4*)(X + (size_t)t * 1024 + d0), xb = *(const float4*)(X + (size_t)t * 1024 + d0 + 4);
      const float xv[8] = {xa.x, xa.y, xa.z, xa.w, xb.x, xb.y, xb.z, xb.w};
#pragma unroll
      for (int i = 0; i < 8; ++i) v[half * 8 + i] = DN_ALPHA * xv[i] + md[5120 + d0 + i] * acc[half * 8 + i];
    }
    const float* gam = P.ln_g + (size_t)(l * 2 + 1) * 1024;
    const float* bet = P.ln_b + (size_t)(l * 2 + 1) * 1024;
    if (l == NL - 1) {
      ln_finish<1>(v, (size_t)t, lane, gam, bet, nullptr, nullptr, P.out, nullptr);
    } else {
      const float* mdn = MODS + (size_t)((l + 1) * 4 + b) * 6144;
      ln_finish<1>(v, (size_t)t, lane, gam, bet, mdn, mdn + 1024, X, Hn);
    }
  }
}

#define XB_TMO      128
#define XB_XCNT(j)  (256  + 64 * (j))
#define XB_XSUB(j)  (1280 + 64 * (j))
#define XB_XGEN(j)  (2304 + 64 * (j))
#define XB_TOP      3328
#define XB_TOPGEN   3392
#define XCD_BAR_WORDS 3456
#define XB_SPIN_CAP (1u << 18)
#define LAS __attribute__((address_space(3)))

__device__ __forceinline__ unsigned xb_ld(unsigned* p)              { return __hip_atomic_load(p, __ATOMIC_RELAXED, __HIP_MEMORY_SCOPE_AGENT); }
__device__ __forceinline__ unsigned xb_add(unsigned* p, unsigned v) { return __hip_atomic_fetch_add(p, v, __ATOMIC_RELAXED, __HIP_MEMORY_SCOPE_AGENT); }
__device__ __forceinline__ unsigned xb_xcc_id() { return (unsigned)__builtin_amdgcn_s_getreg((3 << 11) | 20) & 0xFu; }
#define XB_SPIN(cond, bar) do { unsigned _sp = 0; while (cond) { __builtin_amdgcn_s_sleep(1); \
    if ((++_sp & 255u) == 0u) { if (xb_ld(&(bar)[XB_TMO])) break; if (_sp > XB_SPIN_CAP) { atomicAdd(&(bar)[XB_TMO], 1u); break; } } } } while (0)

struct XcdBarrier {
    unsigned* bar; unsigned x;
    volatile LAS unsigned* st;
};

__device__ __forceinline__ XcdBarrier xcd_barrier_post(unsigned* bar, volatile LAS unsigned* st) {
    XcdBarrier b; b.bar = bar; b.x = xb_xcc_id(); b.st = st;
    if (threadIdx.x == 0) (void)xb_add(&bar[XB_XCNT(b.x)], 1u);
    return b;
}
__device__ __forceinline__ void xcd_barrier_complete(unsigned* bar, unsigned x, unsigned& nloc, unsigned& nx) {
    const unsigned G = gridDim.x * gridDim.y * gridDim.z;
    unsigned sum, cnt, mine, sp = 0u;
    for (;;) {
        sum = 0u; cnt = 0u; mine = 0u;
#pragma unroll
        for (unsigned j = 0; j < 16; ++j) { const unsigned c = xb_ld(&bar[XB_XCNT(j)]); sum += c; cnt += (c > 0u) ? 1u : 0u; mine = (j == x) ? c : mine; }
        if (sum == G) break;
        __builtin_amdgcn_s_sleep(1);
        if ((++sp & 255u) == 0u) { if (xb_ld(&bar[XB_TMO])) break; if (sp > XB_SPIN_CAP) { atomicAdd(&bar[XB_TMO], 1u); break; } }
    }
    nloc = mine > 0u ? mine : 1u; nx = cnt > 0u ? cnt : 1u;
}

__device__ __forceinline__ void xcd_barrier(const XcdBarrier& b) {
    asm volatile("s_waitcnt vmcnt(0)" ::: "memory");
    __syncthreads();
    if (threadIdx.x == 0) {
        unsigned* bar = b.bar;
        __builtin_amdgcn_s_waitcnt(0);
        unsigned nloc = b.st[0], nx = b.st[1];
        if (nloc == 0u) { xcd_barrier_complete(bar, b.x, nloc, nx); b.st[0] = nloc; b.st[1] = nx; }
        const unsigned old = xb_add(&bar[XB_XSUB(b.x)], 1u);
        const unsigned gen = old / nloc;
        if (old + 1u == (gen + 1u) * nloc) {
            __builtin_amdgcn_fence(__ATOMIC_RELEASE, "agent");
            asm volatile("s_waitcnt vmcnt(0)" ::: "memory");
            const unsigned og = xb_add(&bar[XB_TOP], 1u);
            const unsigned tg = og / nx;
            if (og + 1u == (tg + 1u) * nx) xb_add(&bar[XB_TOPGEN], 1u);
            else XB_SPIN(xb_ld(&bar[XB_TOPGEN]) == tg, bar);
            __builtin_amdgcn_fence(__ATOMIC_ACQUIRE, "agent");
            xb_add(&bar[XB_XGEN(b.x)], 1u);
            asm volatile("s_waitcnt vmcnt(0)" ::: "memory");
        } else {
            XB_SPIN(xb_ld(&bar[XB_XGEN(b.x)]) == gen, bar);
            __builtin_amdgcn_fence(__ATOMIC_ACQUIRE, "agent");
            asm volatile("s_waitcnt vmcnt(0)" ::: "memory");
        }
    }
    __syncthreads();
}

__global__ void __launch_bounds__(256, 2) mega(Params P) {
  cg::grid_group grid = cg::this_grid();
  __shared__ __attribute__((aligned(16))) char smraw[73728];
  __shared__ uint4 xb_words;
  if (threadIdx.x == 0) xb_words = make_uint4(0u, 0u, 0u, 0u);
  __syncthreads();
  (void)xcd_barrier_post((unsigned*)(P.ws + OFF_BAR), (volatile LAS unsigned*)&xb_words);
#define XBAR() { XcdBarrier b_; b_.bar = (unsigned*)(P.ws + OFF_BAR); b_.x = xb_xcc_id(); b_.st = (volatile LAS unsigned*)&xb_words; xcd_barrier(b_); }
  phase0a(P, smraw);
  grid.sync();
  phase0b(P);
  XBAR()
  for (int l = 0; l < NL; ++l) {
#if DO_MIXER
#if PHM & 1
    for (int rep = 0; rep < REP_G1; ++rep) phase_gemm1(P, l, smraw);
#endif
    XBAR()
#if PHM & 2
    for (int rep = 0; rep < REP_CP; ++rep) phase_cmp_pool(P, l, smraw);
#endif
    XBAR()
#if PHM & 4
    for (int rep = 0; rep < REP_ATT; ++rep) phase_attn(P, l, smraw);
#endif
    XBAR()
#if PHM & 8
    phase_gemm2(P, l, smraw);
#endif
    XBAR()
#endif
    phase_gemm3(P, l, smraw);
    XBAR()
#if DO_PEER
#if PHM & 16
    phase_gemm4(P, l, smraw);
#endif
    XBAR()
#if PHM & 32
    for (int rep = 0; rep < REP_ROUTE; ++rep) phase_route(P, l);
#endif
    XBAR()
#endif
    phase_gather(P, l);
    XBAR()
  }
}

extern "C" void kernel_launch(void* const* d_in, const int* in_sizes, int n_in, void* d_out, int out_size, void* d_ws,
                              size_t ws_size, hipStream_t stream) {
  static int grid_blocks = 0;
  if (!grid_blocks) {
    int dev = 0, cus = 0, per_cu = 0;
    hipGetDevice(&dev);
    hipDeviceGetAttribute(&cus, hipDeviceAttributeMultiprocessorCount, dev);
    hipOccupancyMaxActiveBlocksPerMultiprocessor(&per_cu, mega, 256, 0);
    if (per_cu > 2) per_cu = 2;
    grid_blocks = cus * per_cu;
    if (per_cu < 2 || cus != 256) { fprintf(stderr, "unexpected occupancy %d x %d\n", cus, per_cu); grid_blocks = -1; }
  }
  if (grid_blocks <= 0) return;
  if (ws_size < WS_END) { fprintf(stderr, "workspace too small: %zu < %zu\n", ws_size, (size_t)WS_END); return; }
  Params p{};
  p.x = (const float*)d_in[0]; p.c = (const float*)d_in[1]; p.w_ada = (const float*)d_in[2]; p.b_ada = (const float*)d_in[3];
  p.w_in = (const float*)d_in[4]; p.cmp_pe = (const float*)d_in[5]; p.cmp_w1 = (const float*)d_in[6];
  p.cmp_w2 = (const float*)d_in[7]; p.w_pool = (const float*)d_in[8]; p.pool_scale = (const float*)d_in[9];
  p.w_lift = (const float*)d_in[10]; p.w_o = (const float*)d_in[11]; p.ln_g = (const float*)d_in[12];
  p.ln_b = (const float*)d_in[13]; p.peer_wq = (const float*)d_in[14]; p.peer_keys = (const float*)d_in[15];
  p.peer_u = (const float*)d_in[16]; p.peer_v = (const float*)d_in[17];
  p.out = (float*)d_out; p.ws = (char*)d_ws;
  hipMemsetAsync((char*)d_ws + OFF_BAR, 0, 16384, stream);
  void* args[] = {&p};
  hipError_t e = hipLaunchCooperativeKernel((void*)mega, dim3(grid_blocks), dim3(256), args, 0, stream);
  if (e != hipSuccess) fprintf(stderr, "cooperative launch failed: %s (grid %d)\n", hipGetErrorString(e), grid_blocks);
}
```

```cpp
#include <hip/hip_runtime.h>
#include <hip/hip_cooperative_groups.h>
#include <stdint.h>
#include <cstdio>
namespace cg = cooperative_groups;

typedef unsigned short u16;
typedef __attribute__((ext_vector_type(8))) short bf16x8;
typedef __attribute__((ext_vector_type(4))) short s16x4;
typedef __attribute__((ext_vector_type(16))) float f32x16;
typedef __attribute__((ext_vector_type(4))) float f32x4;
typedef __attribute__((ext_vector_type(2))) float f32x2;
typedef __attribute__((ext_vector_type(4))) unsigned u32x4;
typedef __attribute__((ext_vector_type(2))) unsigned u32x2;
typedef __attribute__((ext_vector_type(2))) __bf16 bf16x2v;

#define DI __device__ __forceinline__
#define MFMA32(a, b, c) __builtin_amdgcn_mfma_f32_32x32x16_bf16((a), (b), (c), 0, 0, 0)
#define MFMA16(a, b, c) __builtin_amdgcn_mfma_f32_16x16x32_bf16((a), (b), (c), 0, 0, 0)

#ifndef DO_MIXER
#define DO_MIXER 1
#endif
#ifndef PHM
#define PHM 255
#endif
#ifndef REP_G1
#define REP_G1 1
#endif
#ifndef REP_ATT
#define REP_ATT 1
#endif
#ifndef REP_ROUTE
#define REP_ROUTE 1
#endif
#ifndef REP_GATHER
#define REP_GATHER 1
#endif
#ifndef REP_CP
#define REP_CP 1
#endif
#ifndef DO_PEER
#define DO_PEER 1
#endif

constexpr int T = 16384, S = 4096, NL = 4;
constexpr int NPAD = 4096;
constexpr float L2E = 1.4426950408889634f;
constexpr float DN_ALPHA = 1.681792830507429f;

constexpr size_t OFF_X = 0;
constexpr size_t OFF_R = OFF_X + (size_t)T * 1024 * 4;
constexpr size_t OFF_H = OFF_R + (size_t)T * 1024 * 4;
constexpr size_t OFF_Q = OFF_H + (size_t)T * 1024 * 2;
constexpr size_t OFF_KV0 = OFF_Q + (size_t)T * 512 * 2;
constexpr size_t OFF_K12 = OFF_KV0 + (size_t)T * 256 * 2;
constexpr size_t OFF_VT = OFF_K12 + (size_t)T * 256 * 2;
constexpr size_t OFF_GATE = OFF_VT + (size_t)T * 256 * 2;
constexpr size_t OFF_PIN = OFF_GATE + (size_t)T * 24 * 4;
constexpr size_t OFF_GM = OFF_PIN + (size_t)T * 512 * 2;
constexpr size_t OFF_KC = OFF_GM + (size_t)T * 2048 * 2;
constexpr size_t OFF_VCT = OFF_KC + (size_t)4 * 2 * 256 * 64 * 2;
constexpr size_t OFF_OPOOL = OFF_VCT + (size_t)4 * 2 * 256 * 64 * 2;
constexpr size_t OFF_OATT = OFF_OPOOL + (size_t)T * 512 * 2;
constexpr size_t OFF_OACC = OFF_OATT + (size_t)T * 512 * 2;
constexpr size_t OFF_MERGED = OFF_OACC + (size_t)T * 512 * 4;
constexpr size_t OFF_PQ = OFF_MERGED + (size_t)T * 1024 * 2;
constexpr size_t OFF_EIDX = OFF_PQ + (size_t)T * 1024 * 2;
constexpr size_t OFF_EG = OFF_EIDX + (size_t)T * 128 * 4;
constexpr size_t OFF_MODS = OFF_EG + (size_t)T * 128 * 4;
constexpr size_t OFF_ROPE = OFF_MODS + (size_t)NL * 4 * 6144 * 4;
constexpr size_t OFF_CBIAS = OFF_ROPE + (size_t)4096 * 16 * 4;
constexpr size_t OFF_WIN = OFF_CBIAS + 16384;
constexpr size_t OFF_LIFT = OFF_WIN + (size_t)NL * NPAD * 1024 * 2;
constexpr size_t OFF_WO = OFF_LIFT + (size_t)NL * 2 * 1024 * 512 * 2;
constexpr size_t OFF_WQ = OFF_WO + (size_t)NL * 1024 * 1024 * 2;
constexpr size_t OFF_W1T = OFF_WQ + (size_t)NL * 1024 * 1024 * 2;
constexpr size_t OFF_W2T = OFF_W1T + (size_t)NL * 2 * 64 * 2048 * 2;
constexpr size_t OFF_WPT = OFF_W2T + (size_t)NL * 2 * 64 * 64 * 2;
constexpr size_t OFF_KEYS = OFF_WPT + (size_t)NL * 4 * 128 * 128 * 2;
constexpr size_t OFF_U = OFF_KEYS + (size_t)NL * 8 * 2 * 128 * 64 * 2;
constexpr size_t OFF_V = OFF_U + (size_t)NL * 16384 * 1024;
constexpr size_t OFF_USC = OFF_V + (size_t)NL * 16384 * 1024;
constexpr size_t OFF_VSC = OFF_USC + (size_t)NL * 16384 * 4;
constexpr size_t OFF_STATS = OFF_VSC + (size_t)NL * 16384 * 4;
constexpr size_t OFF_BAR = OFF_STATS + (size_t)T * 2 * 4;
constexpr int MT_CNT_WORD = 3600;
constexpr size_t WS_END = OFF_BAR + 16384;

struct Params {
  const float *x, *c, *w_ada, *b_ada, *w_in, *cmp_pe, *cmp_w1, *cmp_w2, *w_pool, *pool_scale, *w_lift, *w_o, *ln_g,
      *ln_b, *peer_wq, *peer_keys, *peer_u, *peer_v;
  float* out;
  char* ws;
};

DI int otid() { int t = threadIdx.x; asm volatile("" : "+v"(t)); return t; }
DI int crow(int e, int h) { return (e & 3) + 8 * (e >> 2) + 4 * h; }
DI unsigned pk2(float a, float b) {
  f32x2 f = {a, b};
  bf16x2v r = __builtin_convertvector(f, bf16x2v);
  return __builtin_bit_cast(unsigned, r);
}
DI u16 f2bf(float a) { return (u16)(pk2(a, 0.f) & 0xffffu); }
DI float bflo(unsigned u) { return __uint_as_float(u << 16); }
DI float bfhi(unsigned u) { return __uint_as_float(u & 0xffff0000u); }
DI float bf2f(u16 v) { return __uint_as_float(((unsigned)v) << 16); }
DI float ex2(float x) { return __builtin_amdgcn_exp2f(x); }
DI float sigmoidf_(float x) { return 1.f / (1.f + __expf(-x)); }
DI float gelu_tanh(float x) {
  float u = 0.7978845608028654f * (x + 0.044715f * x * x * x);
  float e = __expf(2.f * u);
  float th = 1.f - 2.f / (e + 1.f);
  return 0.5f * x * (1.f + th);
}
DI f32x16 zero16() {
  f32x16 z;
#pragma unroll
  for (int i = 0; i < 16; ++i) z[i] = 0.f;
  return z;
}
DI float wsum(float v) {
#pragma unroll
  for (int o = 32; o > 0; o >>= 1) v += __shfl_xor(v, o);
  return v;
}
DI unsigned umax_(unsigned a, unsigned b) { return a > b ? a : b; }
DI unsigned shx(unsigned v, int m) { return (unsigned)__shfl_xor((int)v, m); }

constexpr int G_LS = 40;
constexpr int G_STG = (128 + 256) * G_LS;
DI void gemm_main(const u16* A, int lda, const u16* B, int ldb, int K, int m0, int n0, f32x16 (&acc)[2][4], u16* sm) {
  const int tid = otid(), lane = tid & 63, w = tid >> 6, wm = w >> 1, wn = w & 1, r = lane & 31, h = lane >> 5;
  const int lrow = tid >> 2, lk = (tid & 3) * 8;
  const unsigned voa = (unsigned)(lrow * lda + lk) * 2u;
  const unsigned vob = (unsigned)((4 * (lrow & 31) + (lrow >> 5)) * ldb + lk) * 2u;
  const char* Ab0 = (const char*)(A + (size_t)m0 * lda);
  const char* Bb0 = (const char*)(B + (size_t)n0 * ldb);
  const size_t sa = (size_t)64 * lda * 2, sb = (size_t)64 * ldb * 2;
  u32x4 ra0[2], rb0[4], ra1[2], rb1[4];
#define GLOAD(RA, RB, K0)                                                                               \
  {                                                                                                     \
    _Pragma("unroll") for (int i = 0; i < 2; ++i) RA[i] = *(const u32x4*)(Ab0 + i * sa + (size_t)(K0) * 2 + voa); \
    _Pragma("unroll") for (int i = 0; i < 4; ++i) RB[i] = *(const u32x4*)(Bb0 + (size_t)((i >> 1) * 128 + (i & 1) * 2) * ldb * 2 + (size_t)(K0) * 2 + vob); \
  }
#define SSTORE(RA, RB, ST)                                                                                      \
  {                                                                                                             \
    _Pragma("unroll") for (int i = 0; i < 2; ++i) *(u32x4*)(sm + (ST) * G_STG + (lrow + 64 * i) * G_LS + lk) = RA[i]; \
    _Pragma("unroll") for (int i = 0; i < 4; ++i) *(u32x4*)(sm + (ST) * G_STG + (128 + lrow + 64 * i) * G_LS + lk) = RB[i]; \
  }
#define COMPUTE(ST)                                                                                   \
  {                                                                                                   \
    const u16* Ab = sm + (ST) * G_STG + (wm * 64 + r) * G_LS + 8 * h;                                 \
    const u16* Bb = sm + (ST) * G_STG + (128 + wn * 128 + r) * G_LS + 8 * h;                          \
    bf16x8 af[2][2];                                                                                  \
    _Pragma("unroll") for (int ks = 0; ks < 2; ++ks) {                                                \
      af[ks][0] = *(const bf16x8*)(Ab + 16 * ks);                                                     \
      af[ks][1] = *(const bf16x8*)(Ab + 32 * G_LS + 16 * ks);                                         \
    }                                                                                                 \
    bf16x8 b0 = *(const bf16x8*)(Bb), b1 = *(const bf16x8*)(Bb + 16);                                 \
    _Pragma("unroll") for (int j = 0; j < 4; ++j) {                                                   \
      bf16x8 nb0 = b0, nb1 = b1;                                                                      \
      if (j < 3) { nb0 = *(const bf16x8*)(Bb + 32 * (j + 1) * G_LS); nb1 = *(const bf16x8*)(Bb + 32 * (j + 1) * G_LS + 16); } \
      acc[0][j] = MFMA32(af[0][0], b0, acc[0][j]);                                                    \
      acc[1][j] = MFMA32(af[0][1], b0, acc[1][j]);                                                    \
      acc[0][j] = MFMA32(af[1][0], b1, acc[0][j]);                                                    \
      acc[1][j] = MFMA32(af[1][1], b1, acc[1][j]);                                                    \
      b0 = nb0; b1 = nb1;                                                                             \
      __builtin_amdgcn_sched_barrier(0);                                                              \
    }                                                                                                 \
  }
  GLOAD(ra0, rb0, 0)
  GLOAD(ra1, rb1, 32)
  __syncthreads();
  SSTORE(ra0, rb0, 0)
  __syncthreads();
  const int nk = K >> 5;
  for (int kt = 0; kt < nk; kt += 2) {
    { const int k2 = (kt + 2 < nk) ? (kt + 2) * 32 : (K - 64); GLOAD(ra0, rb0, k2) }
    __builtin_amdgcn_sched_barrier(0);
    COMPUTE(0)
    SSTORE(ra1, rb1, 1)
    __syncthreads();
    { const int k3 = (kt + 3 < nk) ? (kt + 3) * 32 : (K - 32); GLOAD(ra1, rb1, k3) }
    __builtin_amdgcn_sched_barrier(0);
    COMPUTE(1)
    SSTORE(ra0, rb0, 0)
    __syncthreads();
  }
#undef GLOAD
#undef SSTORE
#undef COMPUTE
}

DI void gemm_tile(int q, int NT, int& mt, int& nt) {
  const int x = blockIdx.x & 7;
  const int PN = NT < 8 ? NT : 8, PM = 64 / PN, NG = NT / PN;
  const int p = q >> 6, mi = q % PM, ni = (q / PM) % PN;
  const int ng = p % NG, mh = p / NG;
  mt = 16 * x + PM * mh + mi;
  nt = PN * ng + ni;
}
#define GEMM_TILE_LOOP(NT) for (int q = blockIdx.x >> 3; q < 16 * (NT); q += gridDim.x >> 3)
#define ACC_ZERO(acc)                                   \
  _Pragma("unroll") for (int i = 0; i < 2; ++i)         \
  _Pragma("unroll") for (int j = 0; j < 4; ++j) acc[i][j] = zero16();

DI int win_colmap(int n) {
  if (n < 1280) return n;
  if (n < 1792) return 1304 + (n - 1280);
  if (n < 3840) return 1816 + (n - 1792);
  if (n < 3864) return 1280 + (n - 3840);
  return -1;
}

DI void tr_family(const float* src, size_t src_mat, int ldsrc, u16* dst, size_t dst_mat, int K, int Ndst, int nmat,
                  int mode, float* sm) {
  const int tid = otid();
  const int tk = K >> 6, tn = Ndst >> 6;
  const int per = tk * tn;
  for (int it = blockIdx.x; it < per * nmat; it += gridDim.x) {
    const int mat = it / per, rem = it % per;
    const int k0 = (rem / tn) * 64, n0 = (rem % tn) * 64;
    const float* s = src + (size_t)mat * src_mat;
    u16* d = dst + (size_t)mat * dst_mat;
    const int tx = tid & 63, ty = tid >> 6;
    const int nd = n0 + tx;
    const int ns = (mode == 1) ? win_colmap(nd) : nd;
    __syncthreads();
    float tv[16];
#pragma unroll
    for (int i = 0; i < 16; ++i) tv[i] = (ns >= 0) ? s[(size_t)(k0 + ty + 4 * i) * ldsrc + ns] : 0.f;
#pragma unroll
    for (int i = 0; i < 16; ++i) sm[(ty + 4 * i) * 65 + tx] = tv[i];
    __syncthreads();
    const int nr = tid >> 2, kseg = (tid & 3) * 16;
    unsigned pkd[8];
#pragma unroll
    for (int j = 0; j < 8; ++j) pkd[j] = pk2(sm[(kseg + 2 * j) * 65 + nr], sm[(kseg + 2 * j + 1) * 65 + nr]);
    uint4* dp = (uint4*)(d + (size_t)(n0 + nr) * K + k0 + kseg);
    dp[0] = make_uint4(pkd[0], pkd[1], pkd[2], pkd[3]);
    dp[1] = make_uint4(pkd[4], pkd[5], pkd[6], pkd[7]);
  }
}

DI void conv_plain(const float* src, u16* dst, size_t n) {
  const size_t gt = (size_t)blockIdx.x * 256 + otid(), gs = (size_t)gridDim.x * 256;
  for (size_t i = gt; i < n / 8; i += gs) {
    const float4 a = ((const float4*)src)[2 * i], b = ((const float4*)src)[2 * i + 1];
    ((uint4*)dst)[i] = make_uint4(pk2(a.x, a.y), pk2(a.z, a.w), pk2(b.x, b.y), pk2(b.z, b.w));
  }
}

DI void conv_fp8_rows(const float* src, unsigned char* dst, float* inv_scale, int nrows) {
  const int tid = otid(), lane = tid & 63, w = tid >> 6;
  for (int row0 = (blockIdx.x * 4 + w) * 4; row0 < nrows; row0 += gridDim.x * 16) {
    f32x4 v[4][4];
#pragma unroll
    for (int rr = 0; rr < 4; ++rr) {
      const f32x4* sp = (const f32x4*)(src + (size_t)(row0 + rr) * 1024 + lane * 16);
#pragma unroll
      for (int q = 0; q < 4; ++q) v[rr][q] = __builtin_nontemporal_load(sp + q);
    }
#pragma unroll
    for (int rr = 0; rr < 4; ++rr) {
      float am = 0.f;
#pragma unroll
      for (int q = 0; q < 4; ++q)
        am = fmaxf(am, fmaxf(fmaxf(fabsf(v[rr][q].x), fabsf(v[rr][q].y)), fmaxf(fabsf(v[rr][q].z), fabsf(v[rr][q].w))));
#pragma unroll
      for (int o = 32; o > 0; o >>= 1) am = fmaxf(am, __shfl_xor(am, o));
      const float sc = (am > 0.f) ? (6.f / am) : 1.f;
      u32x2 out;
#pragma unroll
      for (int d = 0; d < 2; ++d) {
        unsigned wd = 0u;
        wd = __builtin_amdgcn_cvt_scalef32_pk_fp4_f32(wd, v[rr][2 * d].x * sc, v[rr][2 * d].y * sc, 1.0f, 0);
        wd = __builtin_amdgcn_cvt_scalef32_pk_fp4_f32(wd, v[rr][2 * d].z * sc, v[rr][2 * d].w * sc, 1.0f, 1);
        wd = __builtin_amdgcn_cvt_scalef32_pk_fp4_f32(wd, v[rr][2 * d + 1].x * sc, v[rr][2 * d + 1].y * sc, 1.0f, 2);
        wd = __builtin_amdgcn_cvt_scalef32_pk_fp4_f32(wd, v[rr][2 * d + 1].z * sc, v[rr][2 * d + 1].w * sc, 1.0f, 3);
        out[d] = wd;
      }
      *(u32x2*)(dst + (size_t)(row0 + rr) * 512 + lane * 8) = out;
      if (lane == 0) inv_scale[row0 + rr] = (am > 0.f) ? (am / 6.f) : 1.f;
    }
  }
}

DI void convert_layer_weights(const Params& P, int l, float* smf) {
  tr_family(P.w_in + (size_t)l * 1024 * 3864, 0, 3864, (u16*)(P.ws + OFF_WIN) + (size_t)l * NPAD * 1024, 0, 1024, NPAD, 1, 1, smf);
  tr_family(P.w_lift + (size_t)l * 2 * 512 * 1024, (size_t)512 * 1024, 1024, (u16*)(P.ws + OFF_LIFT) + (size_t)l * 2 * 1024 * 512,
            (size_t)1024 * 512, 512, 1024, 2, 0, smf);
  tr_family(P.w_o + (size_t)l * 1024 * 1024, 0, 1024, (u16*)(P.ws + OFF_WO) + (size_t)l * 1024 * 1024, 0, 1024, 1024, 1, 0, smf);
  tr_family(P.peer_wq + (size_t)l * 1024 * 1024, 0, 1024, (u16*)(P.ws + OFF_WQ) + (size_t)l * 1024 * 1024, 0, 1024, 1024, 1, 0, smf);
  tr_family(P.cmp_w1 + (size_t)l * 2 * 2048 * 64, (size_t)2048 * 64, 64, (u16*)(P.ws + OFF_W1T) + (size_t)l * 2 * 64 * 2048,
            (size_t)64 * 2048, 2048, 64, 2, 0, smf);
  tr_family(P.cmp_w2 + (size_t)l * 2 * 64 * 64, (size_t)64 * 64, 64, (u16*)(P.ws + OFF_W2T) + (size_t)l * 2 * 64 * 64,
            (size_t)64 * 64, 64, 64, 2, 0, smf);
  tr_family(P.w_pool + (size_t)l * 4 * 128 * 128, (size_t)128 * 128, 128, (u16*)(P.ws + OFF_WPT) + (size_t)l * 4 * 128 * 128,
            (size_t)128 * 128, 128, 128, 4, 0, smf);
  conv_plain(P.peer_keys + (size_t)l * 8 * 2 * 128 * 64, (u16*)(P.ws + OFF_KEYS) + (size_t)l * 8 * 2 * 128 * 64,
             (size_t)8 * 2 * 128 * 64);
  __syncthreads();
}
DI void convert_layer_peer(const Params& P, int l) {
#if DO_PEER
  conv_fp8_rows(P.peer_u + (size_t)l * 16384 * 1024, (unsigned char*)(P.ws + OFF_U) + (size_t)l * 16384 * 512,
                (float*)(P.ws + OFF_USC) + (size_t)l * 16384, 16384);
  conv_fp8_rows(P.peer_v + (size_t)l * 16384 * 1024, (unsigned char*)(P.ws + OFF_V) + (size_t)l * 16384 * 512,
                (float*)(P.ws + OFF_VSC) + (size_t)l * 16384, 16384);
#endif
}

DI void phase0a(const Params& P, char* smraw) {
  const int tid = otid(), nb = gridDim.x, bid = blockIdx.x;
  float* smf = (float*)smraw;
  float* MODS = (float*)(P.ws + OFF_MODS);
  {
    float* cact = smf;
    float* red = smf + 4096;
    for (int it = bid; it < 384; it += nb) {
      const int l = it / 96, ch = it % 96;
      __syncthreads();
      for (int i = tid; i < 4096; i += 256) {
        const float v = P.c[i];
        cact[i] = v / (1.f + __expf(-v));
      }
      __syncthreads();
      const int kq = tid >> 6, n = tid & 63, col = ch * 64 + n;
      float a0 = 0, a1 = 0, a2 = 0, a3 = 0;
      const float* wp = P.w_ada + ((size_t)l * 1024 + kq * 256) * 6144 + col;
#pragma unroll 32
      for (int k = 0; k < 256; ++k) {
        const float wv = __builtin_nontemporal_load(wp + (size_t)k * 6144);
        const int kk = kq * 256 + k;
        a0 += cact[kk] * wv;
        a1 += cact[1024 + kk] * wv;
        a2 += cact[2048 + kk] * wv;
        a3 += cact[3072 + kk] * wv;
      }
      red[(kq * 4 + 0) * 64 + n] = a0;
      red[(kq * 4 + 1) * 64 + n] = a1;
      red[(kq * 4 + 2) * 64 + n] = a2;
      red[(kq * 4 + 3) * 64 + n] = a3;
      __syncthreads();
      {
        const int b = tid >> 6;
        const float s = red[(0 * 4 + b) * 64 + n] + red[(1 * 4 + b) * 64 + n] + red[(2 * 4 + b) * 64 + n] +
                        red[(3 * 4 + b) * 64 + n] + P.b_ada[l * 6144 + col];
        MODS[(size_t)(l * 4 + b) * 6144 + col] = s;
      }
    }
  }
  {
    float* ROPE = (float*)(P.ws + OFF_ROPE);
    for (int i = bid * 256 + tid; i < 4096 * 8; i += nb * 256) {
      const int pos = i >> 3, fi = i & 7;
      const float inv = exp2f(-(float)fi * 0.125f * 18.931568569324174f);
      const float ang = (float)pos * inv;
      const double xr = (double)ang * 0.15915494309189535;
      const float fr = (float)(xr - floor(xr));
      ROPE[pos * 16 + fi] = __builtin_amdgcn_cosf(fr);
      ROPE[pos * 16 + 8 + fi] = __builtin_amdgcn_sinf(fr);
    }
  }
  {
    float* CB = (float*)(P.ws + OFF_CBIAS);
    float* red = smf;
    for (int it2 = bid; it2 < 64; it2 += nb) {
      const int it = it2 >> 3, kc = it2 & 7;
      __syncthreads();
      const int kq = tid >> 6, n = tid & 63;
      const float* pe = P.cmp_pe + (size_t)it * 2048 + kc * 256 + kq * 64;
      const float* w1 = P.cmp_w1 + ((size_t)it * 2048 + kc * 256 + kq * 64) * 64 + n;
      float a = 0.f;
#pragma unroll 32
      for (int k = 0; k < 64; ++k) a += pe[k] * w1[(size_t)k * 64];
      red[kq * 64 + n] = a;
      __syncthreads();
      if (tid < 64) CB[(it * 8 + kc) * 64 + tid] = red[tid] + red[64 + tid] + red[128 + tid] + red[192 + tid];
    }
  }
  convert_layer_weights(P, 0, smf);
}

DI void phase0b(const Params& P) {
  const float* MODS = (const float*)(P.ws + OFF_MODS);
  u16* H = (u16*)(P.ws + OFF_H);
  const size_t gt = (size_t)blockIdx.x * 256 + otid(), gs = (size_t)gridDim.x * 256;
  for (size_t i = gt; i < (size_t)T * 128; i += gs) {
    const size_t t = i >> 7;
    const int d0 = (int)(i & 127) * 8;
    const int b = (int)(t >> 12);
    const float* md = MODS + (size_t)b * 6144;
    const float4 a = *(const float4*)(P.x + t * 1024 + d0), c = *(const float4*)(P.x + t * 1024 + d0 + 4);
    const float xv[8] = {a.x, a.y, a.z, a.w, c.x, c.y, c.z, c.w};
    float hv[8];
#pragma unroll
    for (int j = 0; j < 8; ++j) hv[j] = xv[j] * (1.f + md[1024 + d0 + j]) + md[d0 + j];
    *(uint4*)(H + t * 1024 + d0) = make_uint4(pk2(hv[0], hv[1]), pk2(hv[2], hv[3]), pk2(hv[4], hv[5]), pk2(hv[6], hv[7]));
  }
}

DI void phase_gemm1(const Params& P, int l, char* smraw) {
  const u16* H = (const u16*)(P.ws + OFF_H);
  const u16* W = (const u16*)(P.ws + OFF_WIN) + (size_t)l * NPAD * 1024;
  const float* ROPE = (const float*)(P.ws + OFF_ROPE);
  u16* Q = (u16*)(P.ws + OFF_Q);
  u16* KV0 = (u16*)(P.ws + OFF_KV0);
  u16* K12 = (u16*)(P.ws + OFF_K12);
  u16* VT = (u16*)(P.ws + OFF_VT);
  float* GATE = (float*)(P.ws + OFF_GATE);
  u16* PIN = (u16*)(P.ws + OFF_PIN);
  u16* GM = (u16*)(P.ws + OFF_GM);
  {
    float* STATS = (float*)(P.ws + OFF_STATS);
    for (int i = blockIdx.x * 256 + otid(); i < T * 2; i += gridDim.x * 256) STATS[i] = 0.f;
  }
  GEMM_TILE_LOOP(16) {
    int nt, mt;
    gemm_tile(q, 16, mt, nt);
    const int m0 = mt * 128, n0 = nt * 256;
    f32x16 acc[2][4];
    ACC_ZERO(acc)
    gemm_main(H, 1024, W, 1024, 1024, m0, n0, acc, (u16*)smraw);
    const int tid = otid(), lane = tid & 63, w = tid >> 6, wm = w >> 1, wn = w & 1, r = lane & 31, h = lane >> 5;
    const int rb = m0 + wm * 64;
    const int t128 = 2 * nt + wn;
    if ((t128 < 4) || (t128 == 6) || (t128 == 8)) {
      const int rl = r & 15;
#pragma unroll
      for (int i = 0; i < 2; ++i)
#pragma unroll
        for (int e = 0; e < 16; ++e) {
          const int row = rb + 32 * i + crow(e, h);
          const int pos = row & (S - 1);
#pragma unroll
          for (int j = 0; j < 4; ++j) {
            const float v = acc[i][j][e];
            const float pr = __shfl_xor(v, 2);
            const int fi = 4 * (r & 1) + j;
            const float cs = ROPE[pos * 16 + fi], sn = ROPE[pos * 16 + 8 + fi];
            float o = v;
            if (rl < 2) o = v * cs - pr * sn;
            else if (rl < 4) o = pr * sn + v * cs;
            acc[i][j][e] = o;
          }
        }
    }
    if (t128 < 4) {
#pragma unroll
      for (int i = 0; i < 2; ++i)
#pragma unroll
        for (int e = 0; e < 16; ++e) {
          const int row = rb + 32 * i + crow(e, h);
          uint2 pk;
          pk.x = pk2(acc[i][0][e] * 0.125f, acc[i][1][e] * 0.125f);
          pk.y = pk2(acc[i][2][e] * 0.125f, acc[i][3][e] * 0.125f);
          *(uint2*)(Q + (size_t)row * 512 + t128 * 128 + 4 * r) = pk;
        }
    } else if (t128 < 10) {
      const int br = (t128 - 4) >> 1, kvsel = (t128 - 4) & 1;
      if (br == 0 || kvsel == 0) {
        u16* dst = (br == 0) ? (KV0 + kvsel * 128) : (K12 + (br - 1) * 128);
#pragma unroll
        for (int i = 0; i < 2; ++i)
#pragma unroll
          for (int e = 0; e < 16; ++e) {
            const int row = rb + 32 * i + crow(e, h);
            uint2 pk;
            pk.x = pk2(acc[i][0][e], acc[i][1][e]);
            pk.y = pk2(acc[i][2][e], acc[i][3][e]);
            *(uint2*)(dst + (size_t)row * 256 + 4 * r) = pk;
          }
      } else {
#pragma unroll
        for (int i = 0; i < 2; ++i)
#pragma unroll
          for (int j = 0; j < 4; ++j)
#pragma unroll
            for (int a = 0; a < 4; ++a) {
              const int row = rb + 32 * i + 8 * a + 4 * h;
              const int b = row >> 12, sp = row & (S - 1);
              const int g = r >> 4, d = 4 * (r & 15) + j;
              uint2 pk;
              pk.x = pk2(acc[i][j][4 * a], acc[i][j][4 * a + 1]);
              pk.y = pk2(acc[i][j][4 * a + 2], acc[i][j][4 * a + 3]);
              *(uint2*)(VT + ((size_t)(((b * 2 + (br - 1)) * 2 + g) * 64 + d)) * S + sp) = pk;
            }
      }
    } else if (t128 < 14) {
#pragma unroll
      for (int i = 0; i < 2; ++i)
#pragma unroll
        for (int e = 0; e < 16; ++e) {
          const int row = rb + 32 * i + crow(e, h);
          uint2 pk;
          pk.x = pk2(acc[i][0][e], acc[i][1][e]);
          pk.y = pk2(acc[i][2][e], acc[i][3][e]);
          *(uint2*)(PIN + (size_t)row * 512 + (t128 - 10) * 128 + 4 * r) = pk;
        }
    } else if (t128 < 30) {
#pragma unroll
      for (int i = 0; i < 2; ++i)
#pragma unroll
        for (int e = 0; e < 16; ++e) {
          const int row = rb + 32 * i + crow(e, h);
          uint2 pk;
          pk.x = pk2(sigmoidf_(acc[i][0][e]), sigmoidf_(acc[i][1][e]));
          pk.y = pk2(sigmoidf_(acc[i][2][e]), sigmoidf_(acc[i][3][e]));
          *(uint2*)(GM + (size_t)row * 2048 + (t128 - 14) * 128 + 4 * r) = pk;
        }
    } else if (t128 == 30) {
      if (r < 6) {
#pragma unroll
        for (int i = 0; i < 2; ++i)
#pragma unroll
          for (int e = 0; e < 16; ++e) {
            const int row = rb + 32 * i + crow(e, h);
            *(float4*)(GATE + (size_t)row * 24 + 4 * r) = make_float4(sigmoidf_(acc[i][0][e]), sigmoidf_(acc[i][1][e]),
                                                                    sigmoidf_(acc[i][2][e]), sigmoidf_(acc[i][3][e]));
          }
      }
    }
  }
}

DI void phase_cmp_pool(const Params& P, int l, char* smraw) {
  const int tid = otid(), lane = tid & 63, w = tid >> 6, r = lane & 31, h = lane >> 5;
  const u16* KV0 = (const u16*)(P.ws + OFF_KV0);
  const u16* W1T = (const u16*)(P.ws + OFF_W1T);
  const u16* W2T = (const u16*)(P.ws + OFF_W2T);
  const float* CB = (const float*)(P.ws + OFF_CBIAS);
  const float* ROPE = (const float*)(P.ws + OFF_ROPE);
  u16* KC = (u16*)(P.ws + OFF_KC);
  u16* VCT = (u16*)(P.ws + OFF_VCT);
  const u16* PIN = (const u16*)(P.ws + OFF_PIN);
  const u16* WPT = (const u16*)(P.ws + OFF_WPT);
  u16* OPOOL = (u16*)(P.ws + OFF_OPOOL);
  const int NCMP = 128, NPOOL = 1024;
  for (int it = blockIdx.x; it < NCMP + NPOOL; it += gridDim.x) {
    __syncthreads();
    if (it < NCMP) {
      const int ct = it & 7, g = (it >> 3) & 1, b = (it >> 4) & 3, kvsel = it >> 6;
      float* red = (float*)smraw;
      u16* G1 = (u16*)(smraw + 32768);
      const u16* w1 = W1T + (size_t)(l * 2 + kvsel) * 64 * 2048;
      int c = ct * 32 + r;
      if (c > 254) c = 254;
      const u16* abase = KV0 + ((size_t)b * S + 16 * c) * 256 + kvsel * 128 + g * 64;
      f32x16 acc0 = zero16(), acc1 = zero16();
#pragma unroll 16
      for (int ks = 0; ks < 32; ++ks) {
        const int k = w * 512 + 16 * ks + 8 * h;
        const int ll = k >> 6, d = k & 63;
        const bf16x8 a = *(const bf16x8*)(abase + (size_t)ll * 256 + d);
        const bf16x8 b0 = *(const bf16x8*)(w1 + (size_t)r * 2048 + k);
        const bf16x8 b1 = *(const bf16x8*)(w1 + (size_t)(32 + r) * 2048 + k);
        acc0 = MFMA32(a, b0, acc0);
        acc1 = MFMA32(a, b1, acc1);
      }
#pragma unroll
      for (int e = 0; e < 16; ++e) {
        red[(w * 32 + crow(e, h)) * 64 + r] = acc0[e];
        red[(w * 32 + crow(e, h)) * 64 + 32 + r] = acc1[e];
      }
      __syncthreads();
      const float* cb = CB + (l * 2 + kvsel) * 512;
#pragma unroll
      for (int i = 0; i < 8; ++i) {
        const int idx = tid + 256 * i;
        const int row = idx >> 6, col = idx & 63;
        const float bias = ((cb[col] + cb[64 + col]) + (cb[128 + col] + cb[192 + col])) +
                           ((cb[256 + col] + cb[320 + col]) + (cb[384 + col] + cb[448 + col]));
        const float v = red[idx] + red[2048 + idx] + red[4096 + idx] + red[6144 + idx] + bias;
        G1[row * 72 + col] = f2bf(gelu_tanh(v));
      }
      __syncthreads();
      if (w < 2) {
        const u16* w2 = W2T + (size_t)(l * 2 + kvsel) * 64 * 64;
        f32x16 o = zero16();
#pragma unroll
        for (int ks = 0; ks < 4; ++ks) {
          const bf16x8 a = *(const bf16x8*)(G1 + r * 72 + 16 * ks + 8 * h);
          const bf16x8 bb = *(const bf16x8*)(w2 + (size_t)(32 * w + r) * 64 + 16 * ks + 8 * h);
          o = MFMA32(a, bb, o);
        }
        const int n = 32 * w + r;
        if (kvsel == 0) {
#pragma unroll
          for (int e = 0; e < 16; ++e) {
            const int cc = ct * 32 + crow(e, h);
            float v = o[e];
            const float pr = __shfl_xor(v, 8);
            if (w == 0 && r < 16) {
              const int pos = (16 * cc + 31) & (S - 1);
              const float cs = ROPE[pos * 16 + (r & 7)], sn = ROPE[pos * 16 + 8 + (r & 7)];
              v = (r < 8) ? (v * cs - pr * sn) : (pr * sn + v * cs);
            }
            if (cc > 254) v = 0.f;
            KC[((size_t)(b * 2 + g) * 256 + cc) * 64 + n] = f2bf(v);
          }
        } else {
#pragma unroll
          for (int a = 0; a < 4; ++a) {
            const int cc = ct * 32 + 8 * a + 4 * h;
            float v0 = o[4 * a], v1 = o[4 * a + 1], v2 = o[4 * a + 2], v3 = o[4 * a + 3];
            if (cc + 3 > 254) v3 = 0.f;
            uint2 pk;
            pk.x = pk2(v0, v1);
            pk.y = pk2(v2, v3);
            *(uint2*)(VCT + ((size_t)(b * 2 + g) * 64 + n) * 256 + cc) = pk;
          }
        }
      }
    } else {
      const int pi = it - NCMP;
      const int g = pi & 3, tt = pi >> 2;
      const int t0 = tt * 64;
      const int s0 = t0 & (S - 1);
      u16* Pl = (u16*)smraw;
      {
        const int c = tid & 127, half = tid >> 7;
        const int win = 2 << g;
        const u16* pc = PIN + (size_t)(t0 - s0) * 512 + g * 128 + c;
        const int sp0 = s0 + half * 32;
        float sum = 0.f;
        for (int u = sp0 - win; u < sp0; ++u)
          if (u >= 0) sum += bf2f(pc[(size_t)u * 512]);
#pragma unroll 1
        for (int k0 = 0; k0 < 32; k0 += 16) {
          float pv[16], po[16];
#pragma unroll
          for (int k = 0; k < 16; ++k) {
            const int sp = sp0 + k0 + k;
            pv[k] = bf2f(pc[(size_t)sp * 512]);
            po[k] = (sp - win >= 0) ? bf2f(pc[(size_t)(sp - win) * 512]) : 0.f;
          }
#pragma unroll
          for (int k = 0; k < 16; ++k) {
            const int sp = sp0 + k0 + k;
            sum += pv[k];
            sum -= po[k];
            const float cnt = (float)((sp + 1 < win) ? (sp + 1) : win);
            Pl[(half * 32 + k0 + k) * 136 + c] = f2bf(sum / cnt - pv[k]);
          }
        }
      }
      __syncthreads();
      const u16* wp = WPT + (size_t)(l * 4 + g) * 128 * 128;
      f32x16 a0 = zero16(), a1 = zero16();
#pragma unroll
      for (int ks = 0; ks < 8; ++ks) {
        const bf16x8 bb = *(const bf16x8*)(wp + (size_t)(32 * w + r) * 128 + 16 * ks + 8 * h);
        const bf16x8 x0 = *(const bf16x8*)(Pl + r * 136 + 16 * ks + 8 * h);
        const bf16x8 x1 = *(const bf16x8*)(Pl + (32 + r) * 136 + 16 * ks + 8 * h);
        a0 = MFMA32(x0, bb, a0);
        a1 = MFMA32(x1, bb, a1);
      }
      const int n = g * 128 + 32 * w + r;
      const float psc = P.pool_scale[l * 512 + n];
#pragma unroll
      for (int e = 0; e < 16; ++e) {
        OPOOL[(size_t)(t0 + crow(e, h)) * 512 + n] = f2bf(a0[e] * psc);
        OPOOL[(size_t)(t0 + 32 + crow(e, h)) * 512 + n] = f2bf(a1[e] * psc);
      }
    }
  }
}

struct TileRegs { u32x4 k[2], v[2]; };
DI void tile_gload(TileRegs& t, const u16* Kb, size_t ks, const u16* Vb, size_t vs, int tid_) {
  const int tid = otid();
#pragma unroll
  for (int i = 0; i < 2; ++i) {
    const int c = tid + 256 * i, row = c >> 3, c8 = (c & 7) * 8;
    t.k[i] = *(const u32x4*)(Kb + (size_t)row * ks + c8);
    t.v[i] = *(const u32x4*)(Vb + (size_t)row * vs + c8);
  }
}
DI void tile_sstore(const TileRegs& t, u16* Kb, u16* Vb, int tid_) {
  const int tid = otid();
#pragma unroll
  for (int i = 0; i < 2; ++i) {
    const int c = tid + 256 * i, row = c >> 3, c8 = (c & 7) * 8;
    *(u32x4*)(Kb + row * 72 + c8) = t.k[i];
    *(u32x4*)(Vb + row * 72 + c8) = t.v[i];
  }
}

template <int MODE>
DI void attn_step(const u16* Kb, const u16* Vb, const bf16x8 (&qf)[4], f32x16 (&o)[2], float& m, float& l, int hi, int lo,
                  bool act) {
  const int ln_ = otid() & 63, r = ln_ & 31, h = ln_ >> 5;
  f32x16 s[2];
  s[0] = zero16();
  s[1] = zero16();
#pragma unroll
  for (int ks = 0; ks < 4; ++ks) {
    const bf16x8 k0 = *(const bf16x8*)(Kb + r * 72 + 16 * ks + 8 * h);
    const bf16x8 k1 = *(const bf16x8*)(Kb + (32 + r) * 72 + 16 * ks + 8 * h);
    s[0] = MFMA32(k0, qf[ks], s[0]);
    s[1] = MFMA32(k1, qf[ks], s[1]);
  }
  float mx = -1e30f;
#pragma unroll
  for (int mt = 0; mt < 2; ++mt)
#pragma unroll
    for (int e = 0; e < 16; ++e) {
      float sv = s[mt][e];
      const int kc = 32 * mt + (e & 3) + 8 * (e >> 2);
      if (MODE & 1) sv = (kc <= hi) ? sv : -1e30f;
      if (MODE & 2) sv = (kc >= lo) ? sv : -1e30f;
      s[mt][e] = sv;
      mx = fmaxf(mx, sv);
    }
  mx = fmaxf(mx, __shfl_xor(mx, 32));
  if (MODE & 4) mx = act ? mx : -1e30f;
  float alpha = 1.f;
  if (__builtin_amdgcn_ballot_w64((mx - m) > 8.f)) {
    const float mnew = fmaxf(m, mx);
    alpha = ex2((m - mnew) * L2E);
    m = mnew;
#pragma unroll
    for (int dt = 0; dt < 2; ++dt)
#pragma unroll
      for (int e = 0; e < 16; ++e) o[dt][e] *= alpha;
  }
  float mL = fmaxf(m, -1e20f) * L2E;
  if (MODE & 4) mL = act ? mL : 1e30f;
  bf16x8 av[2][2][2];
#pragma unroll
  for (int mt = 0; mt < 2; ++mt)
#pragma unroll
    for (int s2 = 0; s2 < 2; ++s2)
#pragma unroll
      for (int dt = 0; dt < 2; ++dt) {
        const u16* vp = Vb + (32 * dt + r) * 72 + 32 * mt + 16 * s2 + 4 * h;
        const s16x4 lo4 = *(const s16x4*)vp;
        const s16x4 hi4 = *(const s16x4*)(vp + 8);
        av[mt][s2][dt] = __builtin_shufflevector(lo4, hi4, 0, 1, 2, 3, 4, 5, 6, 7);
      }
  float rs = 0.f;
#pragma unroll
  for (int mt = 0; mt < 2; ++mt)
#pragma unroll
    for (int s2 = 0; s2 < 2; ++s2) {
      float p[8];
#pragma unroll
      for (int e = 0; e < 8; ++e) {
        p[e] = ex2(fmaf(s[mt][8 * s2 + e], L2E, -mL));
        rs += p[e];
      }
      u32x4 u;
      u.x = pk2(p[0], p[1]);
      u.y = pk2(p[2], p[3]);
      u.z = pk2(p[4], p[5]);
      u.w = pk2(p[6], p[7]);
      const bf16x8 pb = __builtin_bit_cast(bf16x8, u);
      o[0] = MFMA32(av[mt][s2][0], pb, o[0]);
      o[1] = MFMA32(av[mt][s2][1], pb, o[1]);
      __builtin_amdgcn_sched_barrier(0);
    }
  rs += __shfl_xor(rs, 32);
  l = l * alpha + rs;
}

template <int WM>
DI void attn_flush(const Params& P, f32x16 (&o)[2], float& m, float& l, unsigned (&pacc)[16], int tq0, int g, int br) {
  const int tid = otid(), lane = tid & 63, w = tid >> 6, r = lane & 31, h = lane >> 5;
  const float* GATE = (const float*)(P.ws + OFF_GATE);
  u16* OATT = (u16*)(P.ws + OFF_OATT);
  const int head = g * 4 + w;
  const size_t t = (size_t)tq0 + r;
  const float inv = (l > 0.f) ? (1.f / l) : 0.f;
  const float sc = inv * GATE[t * 24 + g * 12 + w * 3 + br];
  unsigned q0[8], q1[8];
#pragma unroll
  for (int dt = 0; dt < 2; ++dt)
#pragma unroll
    for (int a = 0; a < 4; ++a) {
      float v0 = o[dt][4 * a] * sc, v1 = o[dt][4 * a + 1] * sc, v2 = o[dt][4 * a + 2] * sc, v3 = o[dt][4 * a + 3] * sc;
      const int pi = (dt * 4 + a) * 2;
      if (WM >= 1) {
        v0 += bflo(pacc[pi]); v1 += bfhi(pacc[pi]); v2 += bflo(pacc[pi + 1]); v3 += bfhi(pacc[pi + 1]);
      }
      q0[dt * 4 + a] = pk2(v0, v1);
      q1[dt * 4 + a] = pk2(v2, v3);
      if (WM <= 1) {
        pacc[pi] = q0[dt * 4 + a];
        pacc[pi + 1] = q1[dt * 4 + a];
      }
    }
  if (WM == 2) {
#pragma unroll
    for (int dt = 0; dt < 2; ++dt)
#pragma unroll
      for (int k = 0; k < 2; ++k) {
        const u32x2 ra = __builtin_amdgcn_permlane32_swap(q0[dt * 4 + 2 * k], q0[dt * 4 + 2 * k + 1], false, false);
        const u32x2 rb = __builtin_amdgcn_permlane32_swap(q1[dt * 4 + 2 * k], q1[dt * 4 + 2 * k + 1], false, false);
        const size_t idx = t * 512 + head * 64 + 32 * dt + 16 * k + 8 * h;
        *(uint4*)(OATT + idx) = make_uint4(ra[0], rb[0], ra[1], rb[1]);
      }
  }
  m = -1e30f;
  l = 0.f;
  o[0] = zero16();
  o[1] = zero16();
}

DI void phase_attn_items(const Params& P, char* smraw) {
  const u16* Q = (const u16*)(P.ws + OFF_Q);
  const u16* K12 = (const u16*)(P.ws + OFF_K12);
  const u16* VT = (const u16*)(P.ws + OFF_VT);
  const u16* KC = (const u16*)(P.ws + OFF_KC);
  const u16* VCT = (const u16*)(P.ws + OFF_VCT);
  u16* Ks = (u16*)smraw;
  u16* Vs = Ks + 2 * 64 * 72;
  float* imp = (float*)(smraw + 36864);
  unsigned* selm = (unsigned*)(smraw + 36864 + 8192);
  unsigned* uni = selm + 64;
  for (int pp = blockIdx.x; pp < 1024; pp += gridDim.x) {
    const int phalf = pp & 511;
    const int item = (pp < 512) ? phalf : (1016 - (phalf & ~7) + (phalf & 7));
    const int tid = otid(), lane = tid & 63, w = tid >> 6, r = lane & 31, h = lane >> 5;
    const int cur = 63 - (item >> 4);
    const int half = (item >> 3) & 1, b = (item >> 1) & 3, g = item & 1;
    const int qi = 32 * half + r;
    const int tq0 = b * S + cur * 64 + 32 * half;
    const int head = g * 4 + w;
    __syncthreads();
    for (int i = tid; i < 2048; i += 256) imp[i] = 0.f;
    if (tid < 2) uni[tid] = 0u;
    bf16x8 qf[4];
#pragma unroll
    for (int ks = 0; ks < 4; ++ks)
      qf[ks] = *(const bf16x8*)(Q + (size_t)(tq0 + r) * 512 + head * 64 + 16 * ks + 8 * h);
    f32x16 o[2];
    o[0] = zero16();
    o[1] = zero16();
    float m = -1e30f, l = 0.f;
    TileRegs tr;
    const int nct = ((4 * cur + 2) >> 6) + 1;
    const u16* kcb = KC + (size_t)(b * 2 + g) * 256 * 64;
    const u16* vcb = VCT + (size_t)(b * 2 + g) * 64 * 256;
    const int hcmp = ((cur * 64 + qi - 31) >> 4) - 4 * h;
    int buf = 0;
    tile_gload(tr, kcb, 64, vcb, 256, tid);
    __syncthreads();
    tile_sstore(tr, Ks, Vs, tid);
    __syncthreads();
    for (int i = 0; i < nct; ++i) {
      if (i + 1 < nct) tile_gload(tr, kcb + (size_t)(i + 1) * 64 * 64, 64, vcb + (i + 1) * 64, 256, tid);
      __builtin_amdgcn_sched_barrier(0);
      attn_step<1>(Ks + buf * 4608, Vs + buf * 4608, qf, o, m, l, hcmp - 64 * i, 0, true);
      if (i + 1 < nct) tile_sstore(tr, Ks + (buf ^ 1) * 4608, Vs + (buf ^ 1) * 4608, tid);
      __syncthreads();
      buf ^= 1;
    }
    const float cm = fmaxf(m, -1e20f) * L2E;
    const float cinv = (l > 0.f) ? (1.f / l) : 0.f;
    unsigned pacc[16];
    attn_flush<0>(P, o, m, l, pacc, tq0, g, 0);
    tile_gload(tr, kcb, 64, vcb, 256, tid);
    tile_sstore(tr, Ks + buf * 4608, Vs + buf * 4608, tid);
    __syncthreads();
    for (int i = 0; i < nct; ++i) {
      if (i + 1 < nct) tile_gload(tr, kcb + (size_t)(i + 1) * 64 * 64, 64, vcb + (i + 1) * 64, 256, tid);
      __builtin_amdgcn_sched_barrier(0);
      {
        const u16* Kb = Ks + buf * 4608;
        f32x16 s[2];
        s[0] = zero16();
        s[1] = zero16();
#pragma unroll
        for (int ks = 0; ks < 4; ++ks) {
          const bf16x8 k0 = *(const bf16x8*)(Kb + r * 72 + 16 * ks + 8 * h);
          const bf16x8 k1 = *(const bf16x8*)(Kb + (32 + r) * 72 + 16 * ks + 8 * h);
          s[0] = MFMA32(k0, qf[ks], s[0]);
          s[1] = MFMA32(k1, qf[ks], s[1]);
        }
        const int hq = hcmp - 64 * i;
#pragma unroll
        for (int mt = 0; mt < 2; ++mt)
#pragma unroll
          for (int a = 0; a < 4; ++a) {
            float p[4];
#pragma unroll
            for (int q = 0; q < 4; ++q) {
              const int kc = 32 * mt + 8 * a + q;
              const float pv = ex2(fmaf(s[mt][4 * a + q], L2E, -cm)) * cinv;
              p[q] = (kc <= hq) ? pv : 0.f;
            }
            const int j = 16 * i + 8 * mt + 2 * a + h;
            atomicAdd(&imp[j * 32 + r], 2.f * (p[0] + p[1] + p[2]) + p[3]);
            if (j + 1 < 64) atomicAdd(&imp[(j + 1) * 32 + r], p[3]);
          }
      }
      if (i + 1 < nct) tile_sstore(tr, Ks + (buf ^ 1) * 4608, Vs + (buf ^ 1) * 4608, tid);
      __syncthreads();
      buf ^= 1;
    }
    {
      const int q = 8 * w + (lane & 7), part = lane >> 3;
      unsigned long long mask;
      if (cur <= 15) {
        mask = (2ULL << cur) - 1ULL;
      } else {
        mask = 1ULL | (1ULL << cur);
        for (int itn = 0; itn < 14; ++itn) {
          unsigned best = 0u;
#pragma unroll
          for (int jj = 0; jj < 8; ++jj) {
            const int j = part * 8 + jj;
            const unsigned k = (__float_as_uint(imp[j * 32 + q]) & ~63u) | (unsigned)(63 - j);
            const bool ok = (j >= 1) && (j < cur) && !((mask >> j) & 1ULL);
            best = umax_(best, ok ? k : 0u);
          }
          best = umax_(best, shx(best, 8));
          best = umax_(best, shx(best, 16));
          best = umax_(best, shx(best, 32));
          mask |= 1ULL << (63 - (int)(best & 63u));
        }
      }
      if (part == 0) {
        selm[q * 2] = (unsigned)mask;
        selm[q * 2 + 1] = (unsigned)(mask >> 32);
        atomicOr(&uni[0], (unsigned)mask);
        atomicOr(&uni[1], (unsigned)(mask >> 32));
      }
    }
    __syncthreads();
    unsigned long long um = ((unsigned long long)uni[1] << 32) | uni[0];
    um &= (2ULL << cur) - 1ULL;
    const unsigned long long qm = ((unsigned long long)selm[r * 2 + 1] << 32) | selm[r * 2];
    {
      const u16* kb = K12 + (size_t)(b * S) * 256 + 0 * 128 + g * 64;
      const u16* vb = VT + (size_t)((b * 2 + 0) * 2 + g) * 64 * S;
      int j = __ffsll((long long)um) - 1;
      tile_gload(tr, kb + (size_t)(j * 64) * 256, 256, vb + j * 64, S, tid);
      tile_sstore(tr, Ks + buf * 4608, Vs + buf * 4608, tid);
      __syncthreads();
      while (true) {
        um &= um - 1ULL;
        const int jn = um ? (__ffsll((long long)um) - 1) : -1;
        if (jn >= 0) tile_gload(tr, kb + (size_t)(jn * 64) * 256, 256, vb + jn * 64, S, tid);
        __builtin_amdgcn_sched_barrier(0);
        if (j == cur) {
          attn_step<1>(Ks + buf * 4608, Vs + buf * 4608, qf, o, m, l, qi - 4 * h, 0, true);
        } else {
          attn_step<4>(Ks + buf * 4608, Vs + buf * 4608, qf, o, m, l, 0, 0, (bool)((qm >> j) & 1ULL));
        }
        if (jn >= 0) tile_sstore(tr, Ks + (buf ^ 1) * 4608, Vs + (buf ^ 1) * 4608, tid);
        __syncthreads();
        buf ^= 1;
        if (jn < 0) break;
        j = jn;
      }
      attn_flush<1>(P, o, m, l, pacc, tq0, g, 1);
    }
    {
      const u16* kb = K12 + (size_t)(b * S) * 256 + 1 * 128 + g * 64;
      const u16* vb = VT + (size_t)((b * 2 + 1) * 2 + g) * 64 * S;
      const int j0 = (cur - 8 > 0) ? (cur - 8) : 0;
      tile_gload(tr, kb + (size_t)(j0 * 64) * 256, 256, vb + j0 * 64, S, tid);
      tile_sstore(tr, Ks + buf * 4608, Vs + buf * 4608, tid);
      __syncthreads();
      for (int j = j0; j <= cur; ++j) {
        if (j + 1 <= cur) tile_gload(tr, kb + (size_t)((j + 1) * 64) * 256, 256, vb + (j + 1) * 64, S, tid);
        __builtin_amdgcn_sched_barrier(0);
        if (j == cur) {
          attn_step<1>(Ks + buf * 4608, Vs + buf * 4608, qf, o, m, l, qi - 4 * h, 0, true);
        } else if (j == cur - 8) {
          attn_step<2>(Ks + buf * 4608, Vs + buf * 4608, qf, o, m, l, 0, qi + 1 - 4 * h, true);
        } else {
          attn_step<0>(Ks + buf * 4608, Vs + buf * 4608, qf, o, m, l, 0, 0, true);
        }
        if (j + 1 <= cur) tile_sstore(tr, Ks + (buf ^ 1) * 4608, Vs + (buf ^ 1) * 4608, tid);
        __syncthreads();
        buf ^= 1;
      }
      attn_flush<2>(P, o, m, l, pacc, tq0, g, 2);
    }
  }
}

#define EPI_IDS const int tid = otid(), lane = tid & 63, w = tid >> 6, wm = w >> 1, wn = w & 1, r = lane & 31, h = lane >> 5;
#define EPI_ROWS                                      \
  _Pragma("unroll") for (int i = 0; i < 2; ++i)       \
  _Pragma("unroll") for (int e = 0; e < 16; ++e)

DI void phase_gemm2_pool(const Params& P, int l, char* smraw) {
  const u16* OPOOL = (const u16*)(P.ws + OFF_OPOOL);
  const u16* L1 = (const u16*)(P.ws + OFF_LIFT) + (size_t)(l * 2 + 1) * 1024 * 512;
  const u16* GM = (const u16*)(P.ws + OFF_GM);
  u16* MERGED = (u16*)(P.ws + OFF_MERGED);
  GEMM_TILE_LOOP(4) {
    int nt, mt;
    gemm_tile(q, 4, mt, nt);
    const int m0 = mt * 128, n0 = nt * 256;
    f32x16 acc[2][4];
    ACC_ZERO(acc)
    gemm_main(OPOOL, 512, L1, 512, 512, m0, n0, acc, (u16*)smraw);
    {
      EPI_IDS
      EPI_ROWS {
        const int row = m0 + wm * 64 + 32 * i + crow(e, h), col = n0 + wn * 128 + 4 * r;
        const uint2 gv = *(const uint2*)(GM + (size_t)row * 2048 + 1024 + col);
        uint2 pk;
        pk.x = pk2(acc[i][0][e] * bflo(gv.x), acc[i][1][e] * bfhi(gv.x));
        pk.y = pk2(acc[i][2][e] * bflo(gv.y), acc[i][3][e] * bfhi(gv.y));
        *(uint2*)(MERGED + (size_t)row * 1024 + col) = pk;
      }
    }
  }
  __syncthreads();
}

DI void phase_gemm2(const Params& P, int l, char* smraw) {
  const u16* OATT = (const u16*)(P.ws + OFF_OATT);
  const u16* L0 = (const u16*)(P.ws + OFF_LIFT) + (size_t)(l * 2 + 0) * 1024 * 512;
  const u16* GM = (const u16*)(P.ws + OFF_GM);
  u16* MERGED = (u16*)(P.ws + OFF_MERGED);
  GEMM_TILE_LOOP(4) {
    int nt, mt;
    gemm_tile(q, 4, mt, nt);
    const int m0 = mt * 128, n0 = nt * 256;
    f32x16 acc[2][4];
    ACC_ZERO(acc)
    gemm_main(OATT, 512, L0, 512, 512, m0, n0, acc, (u16*)smraw);
    {
      EPI_IDS
      EPI_ROWS {
        const int row = m0 + wm * 64 + 32 * i + crow(e, h), col = n0 + wn * 128 + 4 * r;
        const uint2 gv = *(const uint2*)(GM + (size_t)row * 2048 + col);
        const uint2 mv = *(const uint2*)(MERGED + (size_t)row * 1024 + col);
        uint2 pk;
        pk.x = pk2(bflo(mv.x) + acc[i][0][e] * bflo(gv.x), bfhi(mv.x) + acc[i][1][e] * bfhi(gv.x));
        pk.y = pk2(bflo(mv.y) + acc[i][2][e] * bflo(gv.y), bfhi(mv.y) + acc[i][3][e] * bfhi(gv.y));
        *(uint2*)(MERGED + (size_t)row * 1024 + col) = pk;
      }
    }
  }
}

DI void phase_attn(const Params& P, int l, char* smraw) {
  const bool side_first = (blockIdx.x >> 8) & 1;
  if (side_first) {
    phase_gemm2_pool(P, l, smraw);
    convert_layer_peer(P, l);
    if (l + 1 < NL) convert_layer_weights(P, l + 1, (float*)smraw);
  }
  phase_attn_items(P, smraw);
  if (!side_first) {
    __syncthreads();
    phase_gemm2_pool(P, l, smraw);
    convert_layer_peer(P, l);
    if (l + 1 < NL) convert_layer_weights(P, l + 1, (float*)smraw);
  }
}

DI float xsum32(float (&p)[32], int lane) {
  float q16[16], q8[8], q4[4], q2[2];
  const bool b16 = lane & 16, b8 = lane & 8, b4 = lane & 4, b2 = lane & 2, b1 = lane & 1;
#pragma unroll
  for (int i = 0; i < 16; ++i) { const float k = b16 ? p[16 + i] : p[i], sd = b16 ? p[i] : p[16 + i]; q16[i] = k + __shfl_xor(sd, 16); }
#pragma unroll
  for (int i = 0; i < 8; ++i) { const float k = b8 ? q16[8 + i] : q16[i], sd = b8 ? q16[i] : q16[8 + i]; q8[i] = k + __shfl_xor(sd, 8); }
#pragma unroll
  for (int i = 0; i < 4; ++i) { const float k = b4 ? q8[4 + i] : q8[i], sd = b4 ? q8[i] : q8[4 + i]; q4[i] = k + __shfl_xor(sd, 4); }
#pragma unroll
  for (int i = 0; i < 2; ++i) { const float k = b2 ? q4[2 + i] : q4[i], sd = b2 ? q4[i] : q4[2 + i]; q2[i] = k + __shfl_xor(sd, 2); }
  const float k = b1 ? q2[1] : q2[0], sd = b1 ? q2[0] : q2[1];
  return k + __shfl_xor(sd, 1);
}

DI void phase_gemm3(const Params& P, int l, char* smraw) {
  const u16* MERGED = (const u16*)(P.ws + OFF_MERGED);
  const u16* WO = (const u16*)(P.ws + OFF_WO) + (size_t)l * 1024 * 1024;
  const float* MODS = (const float*)(P.ws + OFF_MODS);
  const float* Xs = (l == 0) ? P.x : (const float*)(P.ws + OFF_X);
  float* X = (float*)(P.ws + OFF_X);
  u16* H = (u16*)(P.ws + OFF_H);
  float* STATS = (float*)(P.ws + OFF_STATS);
  unsigned* MTC = (unsigned*)(P.ws + OFF_BAR) + MT_CNT_WORD;
  GEMM_TILE_LOOP(4) {
    int nt, mt;
    gemm_tile(q, 4, mt, nt);
    const int m0 = mt * 128, n0 = nt * 256;
    f32x16 acc[2][4];
    ACC_ZERO(acc)
#if DO_MIXER
    gemm_main(MERGED, 1024, WO, 1024, 1024, m0, n0, acc, (u16*)smraw);
#endif
    const int b = m0 >> 12;
    const float* md = MODS + (size_t)(l * 4 + b) * 6144;
    const int tid = otid(), lane = tid & 63, w = tid >> 6, wm = w >> 1, wn = w & 1, r = lane & 31, h = lane >> 5;
    const int cb = n0 + wn * 128 + 4 * r;
    {
      const float4 g1v = *(const float4*)(md + 2048 + cb);
#pragma unroll
      for (int i = 0; i < 2; ++i)
#pragma unroll
        for (int e = 0; e < 16; ++e) {
          const unsigned off = (unsigned)((m0 + wm * 64 + 32 * i + crow(e, h)) * 1024 + cb);
          const float4 xv = *(const float4*)(Xs + off);
          acc[i][0][e] = DN_ALPHA * xv.x + g1v.x * acc[i][0][e];
          acc[i][1][e] = DN_ALPHA * xv.y + g1v.y * acc[i][1][e];
          acc[i][2][e] = DN_ALPHA * xv.z + g1v.z * acc[i][2][e];
          acc[i][3][e] = DN_ALPHA * xv.w + g1v.w * acc[i][3][e];
          if ((e & 7) == 7) __builtin_amdgcn_sched_barrier(0);
        }
    }
    {
      float ts, tq;
      {
        float ps[32];
#pragma unroll
        for (int i = 0; i < 2; ++i)
#pragma unroll
          for (int e = 0; e < 16; ++e) ps[i * 16 + e] = (acc[i][0][e] + acc[i][1][e]) + (acc[i][2][e] + acc[i][3][e]);
        ts = xsum32(ps, lane);
      }
      __builtin_amdgcn_sched_barrier(0);
      {
        float pq[32];
#pragma unroll
        for (int i = 0; i < 2; ++i)
#pragma unroll
          for (int e = 0; e < 16; ++e)
            pq[i * 16 + e] = (acc[i][0][e] * acc[i][0][e] + acc[i][1][e] * acc[i][1][e]) +
                             (acc[i][2][e] * acc[i][2][e] + acc[i][3][e] * acc[i][3][e]);
        tq = xsum32(pq, lane);
      }
      __builtin_amdgcn_sched_barrier(0);
      const int row = m0 + wm * 64 + 32 * (r >> 4) + crow(r & 15, h);
      atomicAdd(&STATS[(size_t)row * 2], ts);
      atomicAdd(&STATS[(size_t)row * 2 + 1], tq);
    }
    asm volatile("s_waitcnt vmcnt(0)" ::: "memory");
    __syncthreads();
    if (otid() == 0) {
      __hip_atomic_fetch_add(&MTC[mt], 1u, __ATOMIC_RELEASE, __HIP_MEMORY_SCOPE_AGENT);
      const unsigned target = 4u * (unsigned)(l + 1);
      unsigned spins = 0;
      while (__hip_atomic_load(&MTC[mt], __ATOMIC_ACQUIRE, __HIP_MEMORY_SCOPE_AGENT) < target) {
        __builtin_amdgcn_s_sleep(1);
        if (++spins > (1u << 22)) break;
      }
    }
    __syncthreads();
    {
      const int tid2 = otid(), lane2 = tid2 & 63, w2 = tid2 >> 6, wm = w2 >> 1, wn = w2 & 1, r = lane2 & 31, h = lane2 >> 5;
      const int cb = n0 + wn * 128 + 4 * r;
      const float4 gm4 = *(const float4*)(P.ln_g + (size_t)(l * 2 + 0) * 1024 + cb);
      const float4 bt4 = *(const float4*)(P.ln_b + (size_t)(l * 2 + 0) * 1024 + cb);
      const float4 sh4 = *(const float4*)(md + 3072 + cb);
      const float4 sc4 = *(const float4*)(md + 4096 + cb);
#pragma unroll
      for (int i = 0; i < 2; ++i)
#pragma unroll
        for (int e = 0; e < 16; ++e) {
          const int row = m0 + wm * 64 + 32 * i + crow(e, h);
          const float sm_ = __hip_atomic_load(&STATS[(size_t)row * 2], __ATOMIC_RELAXED, __HIP_MEMORY_SCOPE_AGENT);
          const float sq_ = __hip_atomic_load(&STATS[(size_t)row * 2 + 1], __ATOMIC_RELAXED, __HIP_MEMORY_SCOPE_AGENT);
          const float mu = sm_ * (1.f / 1024.f);
          const float var = fmaxf(sq_ * (1.f / 1024.f) - mu * mu, 0.f);
          const float rstd = rsqrtf(var + 1e-5f);
          const float x0 = (acc[i][0][e] - mu) * rstd * gm4.x + bt4.x;
          const float x1 = (acc[i][1][e] - mu) * rstd * gm4.y + bt4.y;
          const float x2 = (acc[i][2][e] - mu) * rstd * gm4.z + bt4.z;
          const float x3 = (acc[i][3][e] - mu) * rstd * gm4.w + bt4.w;
          const unsigned idx = (unsigned)(row * 1024 + cb);
          *(float4*)(X + idx) = make_float4(x0, x1, x2, x3);
          uint2 pk;
          pk.x = pk2(x0 * (1.f + sc4.x) + sh4.x, x1 * (1.f + sc4.y) + sh4.y);
          pk.y = pk2(x2 * (1.f + sc4.z) + sh4.z, x3 * (1.f + sc4.w) + sh4.w);
          *(uint2*)(H + idx) = pk;
        }
    }
  }
}

template <int LAYOUT>
DI void ln_finish(float (&v)[16], size_t t, int lane, const float* gam, const float* bet, const float* sh,
                  const float* sc, float* Xo, u16* Ho) {
  float s = 0.f;
#pragma unroll
  for (int i = 0; i < 16; ++i) s += v[i];
  s = wsum(s);
  const float mu = s * (1.f / 1024.f);
  float q = 0.f;
#pragma unroll
  for (int i = 0; i < 16; ++i) { const float d = v[i] - mu; q += d * d; }
  q = wsum(q);
  const float rstd = rsqrtf(q * (1.f / 1024.f) + 1e-5f);
#pragma unroll
  for (int half = 0; half < 2; ++half) {
    const int d0 = LAYOUT ? (lane * 16 + half * 8) : (half * 512 + lane * 8);
    float y[8];
#pragma unroll
    for (int i = 0; i < 8; ++i) y[i] = (v[half * 8 + i] - mu) * rstd * gam[d0 + i] + bet[d0 + i];
    *(float4*)(Xo + t * 1024 + d0) = make_float4(y[0], y[1], y[2], y[3]);
    *(float4*)(Xo + t * 1024 + d0 + 4) = make_float4(y[4], y[5], y[6], y[7]);
    if (Ho) {
      float hv[8];
#pragma unroll
      for (int i = 0; i < 8; ++i) hv[i] = y[i] * (1.f + sc[d0 + i]) + sh[d0 + i];
      *(uint4*)(Ho + t * 1024 + d0) = make_uint4(pk2(hv[0], hv[1]), pk2(hv[2], hv[3]), pk2(hv[4], hv[5]), pk2(hv[6], hv[7]));
    }
  }
}

DI void phase_ln1(const Params& P, int l) {
  const int tid_ = otid(); const int lane = tid_ & 63, w = tid_ >> 6;
  const float* R = (const float*)(P.ws + OFF_R);
  const float* MODS = (const float*)(P.ws + OFF_MODS);
  float* X = (float*)(P.ws + OFF_X);
  u16* H = (u16*)(P.ws + OFF_H);
  for (int t = blockIdx.x * 4 + w; t < T; t += gridDim.x * 4) {
    float v[16];
#pragma unroll
    for (int half = 0; half < 2; ++half) {
      const float4 a = *(const float4*)(R + (size_t)t * 1024 + half * 512 + lane * 8);
      const float4 c = *(const float4*)(R + (size_t)t * 1024 + half * 512 + lane * 8 + 4);
      v[half * 8 + 0] = a.x; v[half * 8 + 1] = a.y; v[half * 8 + 2] = a.z; v[half * 8 + 3] = a.w;
      v[half * 8 + 4] = c.x; v[half * 8 + 5] = c.y; v[half * 8 + 6] = c.z; v[half * 8 + 7] = c.w;
    }
    const int b = t >> 12;
    const float* md = MODS + (size_t)(l * 4 + b) * 6144;
    ln_finish<0>(v, (size_t)t, lane, P.ln_g + (size_t)(l * 2 + 0) * 1024, P.ln_b + (size_t)(l * 2 + 0) * 1024, md + 3072,
              md + 4096, X, H);
  }
}

DI void phase_gemm4(const Params& P, int l, char* smraw) {
  const u16* H = (const u16*)(P.ws + OFF_H);
  const u16* WQ = (const u16*)(P.ws + OFF_WQ) + (size_t)l * 1024 * 1024;
  u16* PQ = (u16*)(P.ws + OFF_PQ);
  GEMM_TILE_LOOP(4) {
    int nt, mt;
    gemm_tile(q, 4, mt, nt);
    const int m0 = mt * 128, n0 = nt * 256;
    f32x16 acc[2][4];
    ACC_ZERO(acc)
    gemm_main(H, 1024, WQ, 1024, 1024, m0, n0, acc, (u16*)smraw);
    EPI_IDS
    EPI_ROWS {
      const int row = m0 + wm * 64 + 32 * i + crow(e, h), col = n0 + wn * 128 + 4 * r;
      uint2 pk;
      pk.x = pk2(acc[i][0][e], acc[i][1][e]);
      pk.y = pk2(acc[i][2][e], acc[i][3][e]);
      *(uint2*)(PQ + (size_t)row * 1024 + col) = pk;
    }
  }
}

DI unsigned sortkey(float f, unsigned lowmask, unsigned lowval) {
  unsigned b = __float_as_uint(f);
  b = (b & 0x80000000u) ? ~b : (b | 0x80000000u);
  return (b & ~lowmask) | lowval;
}
DI float unsortkey(unsigned k, unsigned lowmask) {
  const unsigned b = k & ~lowmask;
  return __uint_as_float((b & 0x80000000u) ? (b & 0x7fffffffu) : ~b);
}
DI float sel4f(int g, float a, float b, float c, float d) { return g == 0 ? a : (g == 1 ? b : (g == 2 ? c : d)); }
DI int sel4i(int g, int a, int b, int c, int d) { return g == 0 ? a : (g == 1 ? b : (g == 2 ? c : d)); }

DI unsigned umin_(unsigned a, unsigned b) { return a < b ? a : b; }
DI void sort32_top16(unsigned (&v)[32]) {
  { const unsigned a_ = v[0], b_ = v[1]; v[0] = umax_(a_, b_); v[1] = umin_(a_, b_); }
  { const unsigned a_ = v[2], b_ = v[3]; v[2] = umin_(a_, b_); v[3] = umax_(a_, b_); }
  { const unsigned a_ = v[4], b_ = v[5]; v[4] = umax_(a_, b_); v[5] = umin_(a_, b_); }
  { const unsigned a_ = v[6], b_ = v[7]; v[6] = umin_(a_, b_); v[7] = umax_(a_, b_); }
  { const unsigned a_ = v[8], b_ = v[9]; v[8] = umax_(a_, b_); v[9] = umin_(a_, b_); }
  { const unsigned a_ = v[10], b_ = v[11]; v[10] = umin_(a_, b_); v[11] = umax_(a_, b_); }
  { const unsigned a_ = v[12], b_ = v[13]; v[12] = umax_(a_, b_); v[13] = umin_(a_, b_); }
  { const unsigned a_ = v[14], b_ = v[15]; v[14] = umin_(a_, b_); v[15] = umax_(a_, b_); }
  { const unsigned a_ = v[16], b_ = v[17]; v[16] = umax_(a_, b_); v[17] = umin_(a_, b_); }
  { const unsigned a_ = v[18], b_ = v[19]; v[18] = umin_(a_, b_); v[19] = umax_(a_, b_); }
  { const unsigned a_ = v[20], b_ = v[21]; v[20] = umax_(a_, b_); v[21] = umin_(a_, b_); }
  { const unsigned a_ = v[22], b_ = v[23]; v[22] = umin_(a_, b_); v[23] = umax_(a_, b_); }
  { const unsigned a_ = v[24], b_ = v[25]; v[24] = umax_(a_, b_); v[25] = umin_(a_, b_); }
  { const unsigned a_ = v[26], b_ = v[27]; v[26] = umin_(a_, b_); v[27] = umax_(a_, b_); }
  { const unsigned a_ = v[28], b_ = v[29]; v[28] = umax_(a_, b_); v[29] = umin_(a_, b_); }
  { const unsigned a_ = v[30], b_ = v[31]; v[30] = umin_(a_, b_); v[31] = umax_(a_, b_); }
  { const unsigned a_ = v[0], b_ = v[2]; v[0] = umax_(a_, b_); v[2] = umin_(a_, b_); }
  { const unsigned a_ = v[1], b_ = v[3]; v[1] = umax_(a_, b_); v[3] = umin_(a_, b_); }
  { const unsigned a_ = v[4], b_ = v[6]; v[4] = umin_(a_, b_); v[6] = umax_(a_, b_); }
  { const unsigned a_ = v[5], b_ = v[7]; v[5] = umin_(a_, b_); v[7] = umax_(a_, b_); }
  { const unsigned a_ = v[8], b_ = v[10]; v[8] = umax_(a_, b_); v[10] = umin_(a_, b_); }
  { const unsigned a_ = v[9], b_ = v[11]; v[9] = umax_(a_, b_); v[11] = umin_(a_, b_); }
  { const unsigned a_ = v[12], b_ = v[14]; v[12] = umin_(a_, b_); v[14] = umax_(a_, b_); }
  { const unsigned a_ = v[13], b_ = v[15]; v[13] = umin_(a_, b_); v[15] = umax_(a_, b_); }
  { const unsigned a_ = v[16], b_ = v[18]; v[16] = umax_(a_, b_); v[18] = umin_(a_, b_); }
  { const unsigned a_ = v[17], b_ = v[19]; v[17] = umax_(a_, b_); v[19] = umin_(a_, b_); }
  { const unsigned a_ = v[20], b_ = v[22]; v[20] = umin_(a_, b_); v[22] = umax_(a_, b_); }
  { const unsigned a_ = v[21], b_ = v[23]; v[21] = umin_(a_, b_); v[23] = umax_(a_, b_); }
  { const unsigned a_ = v[24], b_ = v[26]; v[24] = umax_(a_, b_); v[26] = umin_(a_, b_); }
  { const unsigned a_ = v[25], b_ = v[27]; v[25] = umax_(a_, b_); v[27] = umin_(a_, b_); }
  { const unsigned a_ = v[28], b_ = v[30]; v[28] = umin_(a_, b_); v[30] = umax_(a_, b_); }
  { const unsigned a_ = v[29], b_ = v[31]; v[29] = umin_(a_, b_); v[31] = umax_(a_, b_); }
  { const unsigned a_ = v[0], b_ = v[1]; v[0] = umax_(a_, b_); v[1] = umin_(a_, b_); }
  { const unsigned a_ = v[2], b_ = v[3]; v[2] = umax_(a_, b_); v[3] = umin_(a_, b_); }
  { const unsigned a_ = v[4], b_ = v[5]; v[4] = umin_(a_, b_); v[5] = umax_(a_, b_); }
  { const unsigned a_ = v[6], b_ = v[7]; v[6] = umin_(a_, b_); v[7] = umax_(a_, b_); }
  { const unsigned a_ = v[8], b_ = v[9]; v[8] = umax_(a_, b_); v[9] = umin_(a_, b_); }
  { const unsigned a_ = v[10], b_ = v[11]; v[10] = umax_(a_, b_); v[11] = umin_(a_, b_); }
  { const unsigned a_ = v[12], b_ = v[13]; v[12] = umin_(a_, b_); v[13] = umax_(a_, b_); }
  { const unsigned a_ = v[14], b_ = v[15]; v[14] = umin_(a_, b_); v[15] = umax_(a_, b_); }
  { const unsigned a_ = v[16], b_ = v[17]; v[16] = umax_(a_, b_); v[17] = umin_(a_, b_); }
  { const unsigned a_ = v[18], b_ = v[19]; v[18] = umax_(a_, b_); v[19] = umin_(a_, b_); }
  { const unsigned a_ = v[20], b_ = v[21]; v[20] = umin_(a_, b_); v[21] = umax_(a_, b_); }
  { const unsigned a_ = v[22], b_ = v[23]; v[22] = umin_(a_, b_); v[23] = umax_(a_, b_); }
  { const unsigned a_ = v[24], b_ = v[25]; v[24] = umax_(a_, b_); v[25] = umin_(a_, b_); }
  { const unsigned a_ = v[26], b_ = v[27]; v[26] = umax_(a_, b_); v[27] = umin_(a_, b_); }
  { const unsigned a_ = v[28], b_ = v[29]; v[28] = umin_(a_, b_); v[29] = umax_(a_, b_); }
  { const unsigned a_ = v[30], b_ = v[31]; v[30] = umin_(a_, b_); v[31] = umax_(a_, b_); }
  { const unsigned a_ = v[0], b_ = v[4]; v[0] = umax_(a_, b_); v[4] = umin_(a_, b_); }
  { const unsigned a_ = v[1], b_ = v[5]; v[1] = umax_(a_, b_); v[5] = umin_(a_, b_); }
  { const unsigned a_ = v[2], b_ = v[6]; v[2] = umax_(a_, b_); v[6] = umin_(a_, b_); }
  { const unsigned a_ = v[3], b_ = v[7]; v[3] = umax_(a_, b_); v[7] = umin_(a_, b_); }
  { const unsigned a_ = v[8], b_ = v[12]; v[8] = umin_(a_, b_); v[12] = umax_(a_, b_); }
  { const unsigned a_ = v[9], b_ = v[13]; v[9] = umin_(a_, b_); v[13] = umax_(a_, b_); }
  { const unsigned a_ = v[10], b_ = v[14]; v[10] = umin_(a_, b_); v[14] = umax_(a_, b_); }
  { const unsigned a_ = v[11], b_ = v[15]; v[11] = umin_(a_, b_); v[15] = umax_(a_, b_); }
  { const unsigned a_ = v[16], b_ = v[20]; v[16] = umax_(a_, b_); v[20] = umin_(a_, b_); }
  { const unsigned a_ = v[17], b_ = v[21]; v[17] = umax_(a_, b_); v[21] = umin_(a_, b_); }
  { const unsigned a_ = v[18], b_ = v[22]; v[18] = umax_(a_, b_); v[22] = umin_(a_, b_); }
  { const unsigned a_ = v[19], b_ = v[23]; v[19] = umax_(a_, b_); v[23] = umin_(a_, b_); }
  { const unsigned a_ = v[24], b_ = v[28]; v[24] = umin_(a_, b_); v[28] = umax_(a_, b_); }
  { const unsigned a_ = v[25], b_ = v[29]; v[25] = umin_(a_, b_); v[29] = umax_(a_, b_); }
  { const unsigned a_ = v[26], b_ = v[30]; v[26] = umin_(a_, b_); v[30] = umax_(a_, b_); }
  { const unsigned a_ = v[27], b_ = v[31]; v[27] = umin_(a_, b_); v[31] = umax_(a_, b_); }
  { const unsigned a_ = v[0], b_ = v[2]; v[0] = umax_(a_, b_); v[2] = umin_(a_, b_); }
  { const unsigned a_ = v[1], b_ = v[3]; v[1] = umax_(a_, b_); v[3] = umin_(a_, b_); }
  { const unsigned a_ = v[4], b_ = v[6]; v[4] = umax_(a_, b_); v[6] = umin_(a_, b_); }
  { const unsigned a_ = v[5], b_ = v[7]; v[5] = umax_(a_, b_); v[7] = umin_(a_, b_); }
  { const unsigned a_ = v[8], b_ = v[10]; v[8] = umin_(a_, b_); v[10] = umax_(a_, b_); }
  { const unsigned a_ = v[9], b_ = v[11]; v[9] = umin_(a_, b_); v[11] = umax_(a_, b_); }
  { const unsigned a_ = v[12], b_ = v[14]; v[12] = umin_(a_, b_); v[14] = umax_(a_, b_); }
  { const unsigned a_ = v[13], b_ = v[15]; v[13] = umin_(a_, b_); v[15] = umax_(a_, b_); }
  { const unsigned a_ = v[16], b_ = v[18]; v[16] = umax_(a_, b_); v[18] = umin_(a_, b_); }
  { const unsigned a_ = v[17], b_ = v[19]; v[17] = umax_(a_, b_); v[19] = umin_(a_, b_); }
  { const unsigned a_ = v[20], b_ = v[22]; v[20] = umax_(a_, b_); v[22] = umin_(a_, b_); }
  { const unsigned a_ = v[21], b_ = v[23]; v[21] = umax_(a_, b_); v[23] = umin_(a_, b_); }
  { const unsigned a_ = v[24], b_ = v[26]; v[24] = umin_(a_, b_); v[26] = umax_(a_, b_); }
  { const unsigned a_ = v[25], b_ = v[27]; v[25] = umin_(a_, b_); v[27] = umax_(a_, b_); }
  { const unsigned a_ = v[28], b_ = v[30]; v[28] = umin_(a_, b_); v[30] = umax_(a_, b_); }
  { const unsigned a_ = v[29], b_ = v[31]; v[29] = umin_(a_, b_); v[31] = umax_(a_, b_); }
  { const unsigned a_ = v[0], b_ = v[1]; v[0] = umax_(a_, b_); v[1] = umin_(a_, b_); }
  { const unsigned a_ = v[2], b_ = v[3]; v[2] = umax_(a_, b_); v[3] = umin_(a_, b_); }
  { const unsigned a_ = v[4], b_ = v[5]; v[4] = umax_(a_, b_); v[5] = umin_(a_, b_); }
  { const unsigned a_ = v[6], b_ = v[7]; v[6] = umax_(a_, b_); v[7] = umin_(a_, b_); }
  { const unsigned a_ = v[8], b_ = v[9]; v[8] = umin_(a_, b_); v[9] = umax_(a_, b_); }
  { const unsigned a_ = v[10], b_ = v[11]; v[10] = umin_(a_, b_); v[11] = umax_(a_, b_); }
  { const unsigned a_ = v[12], b_ = v[13]; v[12] = umin_(a_, b_); v[13] = umax_(a_, b_); }
  { const unsigned a_ = v[14], b_ = v[15]; v[14] = umin_(a_, b_); v[15] = umax_(a_, b_); }
  { const unsigned a_ = v[16], b_ = v[17]; v[16] = umax_(a_, b_); v[17] = umin_(a_, b_); }
  { const unsigned a_ = v[18], b_ = v[19]; v[18] = umax_(a_, b_); v[19] = umin_(a_, b_); }
  { const unsigned a_ = v[20], b_ = v[21]; v[20] = umax_(a_, b_); v[21] = umin_(a_, b_); }
  { const unsigned a_ = v[22], b_ = v[23]; v[22] = umax_(a_, b_); v[23] = umin_(a_, b_); }
  { const unsigned a_ = v[24], b_ = v[25]; v[24] = umin_(a_, b_); v[25] = umax_(a_, b_); }
  { const unsigned a_ = v[26], b_ = v[27]; v[26] = umin_(a_, b_); v[27] = umax_(a_, b_); }
  { const unsigned a_ = v[28], b_ = v[29]; v[28] = umin_(a_, b_); v[29] = umax_(a_, b_); }
  { const unsigned a_ = v[30], b_ = v[31]; v[30] = umin_(a_, b_); v[31] = umax_(a_, b_); }
  { const unsigned a_ = v[0], b_ = v[8]; v[0] = umax_(a_, b_); v[8] = umin_(a_, b_); }
  { const unsigned a_ = v[1], b_ = v[9]; v[1] = umax_(a_, b_); v[9] = umin_(a_, b_); }
  { const unsigned a_ = v[2], b_ = v[10]; v[2] = umax_(a_, b_); v[10] = umin_(a_, b_); }
  { const unsigned a_ = v[3], b_ = v[11]; v[3] = umax_(a_, b_); v[11] = umin_(a_, b_); }
  { const unsigned a_ = v[4], b_ = v[12]; v[4] = umax_(a_, b_); v[12] = umin_(a_, b_); }
  { const unsigned a_ = v[5], b_ = v[13]; v[5] = umax_(a_, b_); v[13] = umin_(a_, b_); }
  { const unsigned a_ = v[6], b_ = v[14]; v[6] = umax_(a_, b_); v[14] = umin_(a_, b_); }
  { const unsigned a_ = v[7], b_ = v[15]; v[7] = umax_(a_, b_); v[15] = umin_(a_, b_); }
  { const unsigned a_ = v[16], b_ = v[24]; v[16] = umin_(a_, b_); v[24] = umax_(a_, b_); }
  { const unsigned a_ = v[17], b_ = v[25]; v[17] = umin_(a_, b_); v[25] = umax_(a_, b_); }
  { const unsigned a_ = v[18], b_ = v[26]; v[18] = umin_(a_, b_); v[26] = umax_(a_, b_); }
  { const unsigned a_ = v[19], b_ = v[27]; v[19] = umin_(a_, b_); v[27] = umax_(a_, b_); }
  { const unsigned a_ = v[20], b_ = v[28]; v[20] = umin_(a_, b_); v[28] = umax_(a_, b_); }
  { const unsigned a_ = v[21], b_ = v[29]; v[21] = umin_(a_, b_); v[29] = umax_(a_, b_); }
  { const unsigned a_ = v[22], b_ = v[30]; v[22] = umin_(a_, b_); v[30] = umax_(a_, b_); }
  { const unsigned a_ = v[23], b_ = v[31]; v[23] = umin_(a_, b_); v[31] = umax_(a_, b_); }
  { const unsigned a_ = v[0], b_ = v[4]; v[0] = umax_(a_, b_); v[4] = umin_(a_, b_); }
  { const unsigned a_ = v[1], b_ = v[5]; v[1] = umax_(a_, b_); v[5] = umin_(a_, b_); }
  { const unsigned a_ = v[2], b_ = v[6]; v[2] = umax_(a_, b_); v[6] = umin_(a_, b_); }
  { const unsigned a_ = v[3], b_ = v[7]; v[3] = umax_(a_, b_); v[7] = umin_(a_, b_); }
  { const unsigned a_ = v[8], b_ = v[12]; v[8] = umax_(a_, b_); v[12] = umin_(a_, b_); }
  { const unsigned a_ = v[9], b_ = v[13]; v[9] = umax_(a_, b_); v[13] = umin_(a_, b_); }
  { const unsigned a_ = v[10], b_ = v[14]; v[10] = umax_(a_, b_); v[14] = umin_(a_, b_); }
  { const unsigned a_ = v[11], b_ = v[15]; v[11] = umax_(a_, b_); v[15] = umin_(a_, b_); }
  { const unsigned a_ = v[16], b_ = v[20]; v[16] = umin_(a_, b_); v[20] = umax_(a_, b_); }
  { const unsigned a_ = v[17], b_ = v[21]; v[17] = umin_(a_, b_); v[21] = umax_(a_, b_); }
  { const unsigned a_ = v[18], b_ = v[22]; v[18] = umin_(a_, b_); v[22] = umax_(a_, b_); }
  { const unsigned a_ = v[19], b_ = v[23]; v[19] = umin_(a_, b_); v[23] = umax_(a_, b_); }
  { const unsigned a_ = v[24], b_ = v[28]; v[24] = umin_(a_, b_); v[28] = umax_(a_, b_); }
  { const unsigned a_ = v[25], b_ = v[29]; v[25] = umin_(a_, b_); v[29] = umax_(a_, b_); }
  { const unsigned a_ = v[26], b_ = v[30]; v[26] = umin_(a_, b_); v[30] = umax_(a_, b_); }
  { const unsigned a_ = v[27], b_ = v[31]; v[27] = umin_(a_, b_); v[31] = umax_(a_, b_); }
  { const unsigned a_ = v[0], b_ = v[2]; v[0] = umax_(a_, b_); v[2] = umin_(a_, b_); }
  { const unsigned a_ = v[1], b_ = v[3]; v[1] = umax_(a_, b_); v[3] = umin_(a_, b_); }
  { const unsigned a_ = v[4], b_ = v[6]; v[4] = umax_(a_, b_); v[6] = umin_(a_, b_); }
  { const unsigned a_ = v[5], b_ = v[7]; v[5] = umax_(a_, b_); v[7] = umin_(a_, b_); }
  { const unsigned a_ = v[8], b_ = v[10]; v[8] = umax_(a_, b_); v[10] = umin_(a_, b_); }
  { const unsigned a_ = v[9], b_ = v[11]; v[9] = umax_(a_, b_); v[11] = umin_(a_, b_); }
  { const unsigned a_ = v[12], b_ = v[14]; v[12] = umax_(a_, b_); v[14] = umin_(a_, b_); }
  { const unsigned a_ = v[13], b_ = v[15]; v[13] = umax_(a_, b_); v[15] = umin_(a_, b_); }
  { const unsigned a_ = v[16], b_ = v[18]; v[16] = umin_(a_, b_); v[18] = umax_(a_, b_); }
  { const unsigned a_ = v[17], b_ = v[19]; v[17] = umin_(a_, b_); v[19] = umax_(a_, b_); }
  { const unsigned a_ = v[20], b_ = v[22]; v[20] = umin_(a_, b_); v[22] = umax_(a_, b_); }
  { const unsigned a_ = v[21], b_ = v[23]; v[21] = umin_(a_, b_); v[23] = umax_(a_, b_); }
  { const unsigned a_ = v[24], b_ = v[26]; v[24] = umin_(a_, b_); v[26] = umax_(a_, b_); }
  { const unsigned a_ = v[25], b_ = v[27]; v[25] = umin_(a_, b_); v[27] = umax_(a_, b_); }
  { const unsigned a_ = v[28], b_ = v[30]; v[28] = umin_(a_, b_); v[30] = umax_(a_, b_); }
  { const unsigned a_ = v[29], b_ = v[31]; v[29] = umin_(a_, b_); v[31] = umax_(a_, b_); }
  { const unsigned a_ = v[0], b_ = v[1]; v[0] = umax_(a_, b_); v[1] = umin_(a_, b_); }
  { const unsigned a_ = v[2], b_ = v[3]; v[2] = umax_(a_, b_); v[3] = umin_(a_, b_); }
  { const unsigned a_ = v[4], b_ = v[5]; v[4] = umax_(a_, b_); v[5] = umin_(a_, b_); }
  { const unsigned a_ = v[6], b_ = v[7]; v[6] = umax_(a_, b_); v[7] = umin_(a_, b_); }
  { const unsigned a_ = v[8], b_ = v[9]; v[8] = umax_(a_, b_); v[9] = umin_(a_, b_); }
  { const unsigned a_ = v[10], b_ = v[11]; v[10] = umax_(a_, b_); v[11] = umin_(a_, b_); }
  { const unsigned a_ = v[12], b_ = v[13]; v[12] = umax_(a_, b_); v[13] = umin_(a_, b_); }
  { const unsigned a_ = v[14], b_ = v[15]; v[14] = umax_(a_, b_); v[15] = umin_(a_, b_); }
  { const unsigned a_ = v[16], b_ = v[17]; v[16] = umin_(a_, b_); v[17] = umax_(a_, b_); }
  { const unsigned a_ = v[18], b_ = v[19]; v[18] = umin_(a_, b_); v[19] = umax_(a_, b_); }
  { const unsigned a_ = v[20], b_ = v[21]; v[20] = umin_(a_, b_); v[21] = umax_(a_, b_); }
  { const unsigned a_ = v[22], b_ = v[23]; v[22] = umin_(a_, b_); v[23] = umax_(a_, b_); }
  { const unsigned a_ = v[24], b_ = v[25]; v[24] = umin_(a_, b_); v[25] = umax_(a_, b_); }
  { const unsigned a_ = v[26], b_ = v[27]; v[26] = umin_(a_, b_); v[27] = umax_(a_, b_); }
  { const unsigned a_ = v[28], b_ = v[29]; v[28] = umin_(a_, b_); v[29] = umax_(a_, b_); }
  { const unsigned a_ = v[30], b_ = v[31]; v[30] = umin_(a_, b_); v[31] = umax_(a_, b_); }
  v[0] = umax_(v[0], v[16]);
  v[1] = umax_(v[1], v[17]);
  v[2] = umax_(v[2], v[18]);
  v[3] = umax_(v[3], v[19]);
  v[4] = umax_(v[4], v[20]);
  v[5] = umax_(v[5], v[21]);
  v[6] = umax_(v[6], v[22]);
  v[7] = umax_(v[7], v[23]);
  v[8] = umax_(v[8], v[24]);
  v[9] = umax_(v[9], v[25]);
  v[10] = umax_(v[10], v[26]);
  v[11] = umax_(v[11], v[27]);
  v[12] = umax_(v[12], v[28]);
  v[13] = umax_(v[13], v[29]);
  v[14] = umax_(v[14], v[30]);
  v[15] = umax_(v[15], v[31]);
  { const unsigned a_ = v[0], b_ = v[8]; v[0] = umax_(a_, b_); v[8] = umin_(a_, b_); }
  { const unsigned a_ = v[1], b_ = v[9]; v[1] = umax_(a_, b_); v[9] = umin_(a_, b_); }
  { const unsigned a_ = v[2], b_ = v[10]; v[2] = umax_(a_, b_); v[10] = umin_(a_, b_); }
  { const unsigned a_ = v[3], b_ = v[11]; v[3] = umax_(a_, b_); v[11] = umin_(a_, b_); }
  { const unsigned a_ = v[4], b_ = v[12]; v[4] = umax_(a_, b_); v[12] = umin_(a_, b_); }
  { const unsigned a_ = v[5], b_ = v[13]; v[5] = umax_(a_, b_); v[13] = umin_(a_, b_); }
  { const unsigned a_ = v[6], b_ = v[14]; v[6] = umax_(a_, b_); v[14] = umin_(a_, b_); }
  { const unsigned a_ = v[7], b_ = v[15]; v[7] = umax_(a_, b_); v[15] = umin_(a_, b_); }
  { const unsigned a_ = v[0], b_ = v[4]; v[0] = umax_(a_, b_); v[4] = umin_(a_, b_); }
  { const unsigned a_ = v[1], b_ = v[5]; v[1] = umax_(a_, b_); v[5] = umin_(a_, b_); }
  { const unsigned a_ = v[2], b_ = v[6]; v[2] = umax_(a_, b_); v[6] = umin_(a_, b_); }
  { const unsigned a_ = v[3], b_ = v[7]; v[3] = umax_(a_, b_); v[7] = umin_(a_, b_); }
  { const unsigned a_ = v[8], b_ = v[12]; v[8] = umax_(a_, b_); v[12] = umin_(a_, b_); }
  { const unsigned a_ = v[9], b_ = v[13]; v[9] = umax_(a_, b_); v[13] = umin_(a_, b_); }
  { const unsigned a_ = v[10], b_ = v[14]; v[10] = umax_(a_, b_); v[14] = umin_(a_, b_); }
  { const unsigned a_ = v[11], b_ = v[15]; v[11] = umax_(a_, b_); v[15] = umin_(a_, b_); }
  { const unsigned a_ = v[0], b_ = v[2]; v[0] = umax_(a_, b_); v[2] = umin_(a_, b_); }
  { const unsigned a_ = v[1], b_ = v[3]; v[1] = umax_(a_, b_); v[3] = umin_(a_, b_); }
  { const unsigned a_ = v[4], b_ = v[6]; v[4] = umax_(a_, b_); v[6] = umin_(a_, b_); }
  { const unsigned a_ = v[5], b_ = v[7]; v[5] = umax_(a_, b_); v[7] = umin_(a_, b_); }
  { const unsigned a_ = v[8], b_ = v[10]; v[8] = umax_(a_, b_); v[10] = umin_(a_, b_); }
  { const unsigned a_ = v[9], b_ = v[11]; v[9] = umax_(a_, b_); v[11] = umin_(a_, b_); }
  { const unsigned a_ = v[12], b_ = v[14]; v[12] = umax_(a_, b_); v[14] = umin_(a_, b_); }
  { const unsigned a_ = v[13], b_ = v[15]; v[13] = umax_(a_, b_); v[15] = umin_(a_, b_); }
  { const unsigned a_ = v[0], b_ = v[1]; v[0] = umax_(a_, b_); v[1] = umin_(a_, b_); }
  { const unsigned a_ = v[2], b_ = v[3]; v[2] = umax_(a_, b_); v[3] = umin_(a_, b_); }
  { const unsigned a_ = v[4], b_ = v[5]; v[4] = umax_(a_, b_); v[5] = umin_(a_, b_); }
  { const unsigned a_ = v[6], b_ = v[7]; v[6] = umax_(a_, b_); v[7] = umin_(a_, b_); }
  { const unsigned a_ = v[8], b_ = v[9]; v[8] = umax_(a_, b_); v[9] = umin_(a_, b_); }
  { const unsigned a_ = v[10], b_ = v[11]; v[10] = umax_(a_, b_); v[11] = umin_(a_, b_); }
  { const unsigned a_ = v[12], b_ = v[13]; v[12] = umax_(a_, b_); v[13] = umin_(a_, b_); }
  { const unsigned a_ = v[14], b_ = v[15]; v[14] = umax_(a_, b_); v[15] = umin_(a_, b_); }
}
DI void merge16(unsigned (&v)[32], int m) {
  unsigned o[16];
  o[0] = shx(v[15], m);
  o[1] = shx(v[14], m);
  o[2] = shx(v[13], m);
  o[3] = shx(v[12], m);
  o[4] = shx(v[11], m);
  o[5] = shx(v[10], m);
  o[6] = shx(v[9], m);
  o[7] = shx(v[8], m);
  o[8] = shx(v[7], m);
  o[9] = shx(v[6], m);
  o[10] = shx(v[5], m);
  o[11] = shx(v[4], m);
  o[12] = shx(v[3], m);
  o[13] = shx(v[2], m);
  o[14] = shx(v[1], m);
  o[15] = shx(v[0], m);
  v[0] = umax_(v[0], o[0]);
  v[1] = umax_(v[1], o[1]);
  v[2] = umax_(v[2], o[2]);
  v[3] = umax_(v[3], o[3]);
  v[4] = umax_(v[4], o[4]);
  v[5] = umax_(v[5], o[5]);
  v[6] = umax_(v[6], o[6]);
  v[7] = umax_(v[7], o[7]);
  v[8] = umax_(v[8], o[8]);
  v[9] = umax_(v[9], o[9]);
  v[10] = umax_(v[10], o[10]);
  v[11] = umax_(v[11], o[11]);
  v[12] = umax_(v[12], o[12]);
  v[13] = umax_(v[13], o[13]);
  v[14] = umax_(v[14], o[14]);
  v[15] = umax_(v[15], o[15]);
  { const unsigned a_ = v[0], b_ = v[8]; v[0] = umax_(a_, b_); v[8] = umin_(a_, b_); }
  { const unsigned a_ = v[1], b_ = v[9]; v[1] = umax_(a_, b_); v[9] = umin_(a_, b_); }
  { const unsigned a_ = v[2], b_ = v[10]; v[2] = umax_(a_, b_); v[10] = umin_(a_, b_); }
  { const unsigned a_ = v[3], b_ = v[11]; v[3] = umax_(a_, b_); v[11] = umin_(a_, b_); }
  { const unsigned a_ = v[4], b_ = v[12]; v[4] = umax_(a_, b_); v[12] = umin_(a_, b_); }
  { const unsigned a_ = v[5], b_ = v[13]; v[5] = umax_(a_, b_); v[13] = umin_(a_, b_); }
  { const unsigned a_ = v[6], b_ = v[14]; v[6] = umax_(a_, b_); v[14] = umin_(a_, b_); }
  { const unsigned a_ = v[7], b_ = v[15]; v[7] = umax_(a_, b_); v[15] = umin_(a_, b_); }
  { const unsigned a_ = v[0], b_ = v[4]; v[0] = umax_(a_, b_); v[4] = umin_(a_, b_); }
  { const unsigned a_ = v[1], b_ = v[5]; v[1] = umax_(a_, b_); v[5] = umin_(a_, b_); }
  { const unsigned a_ = v[2], b_ = v[6]; v[2] = umax_(a_, b_); v[6] = umin_(a_, b_); }
  { const unsigned a_ = v[3], b_ = v[7]; v[3] = umax_(a_, b_); v[7] = umin_(a_, b_); }
  { const unsigned a_ = v[8], b_ = v[12]; v[8] = umax_(a_, b_); v[12] = umin_(a_, b_); }
  { const unsigned a_ = v[9], b_ = v[13]; v[9] = umax_(a_, b_); v[13] = umin_(a_, b_); }
  { const unsigned a_ = v[10], b_ = v[14]; v[10] = umax_(a_, b_); v[14] = umin_(a_, b_); }
  { const unsigned a_ = v[11], b_ = v[15]; v[11] = umax_(a_, b_); v[15] = umin_(a_, b_); }
  { const unsigned a_ = v[0], b_ = v[2]; v[0] = umax_(a_, b_); v[2] = umin_(a_, b_); }
  { const unsigned a_ = v[1], b_ = v[3]; v[1] = umax_(a_, b_); v[3] = umin_(a_, b_); }
  { const unsigned a_ = v[4], b_ = v[6]; v[4] = umax_(a_, b_); v[6] = umin_(a_, b_); }
  { const unsigned a_ = v[5], b_ = v[7]; v[5] = umax_(a_, b_); v[7] = umin_(a_, b_); }
  { const unsigned a_ = v[8], b_ = v[10]; v[8] = umax_(a_, b_); v[10] = umin_(a_, b_); }
  { const unsigned a_ = v[9], b_ = v[11]; v[9] = umax_(a_, b_); v[11] = umin_(a_, b_); }
  { const unsigned a_ = v[12], b_ = v[14]; v[12] = umax_(a_, b_); v[14] = umin_(a_, b_); }
  { const unsigned a_ = v[13], b_ = v[15]; v[13] = umax_(a_, b_); v[15] = umin_(a_, b_); }
  { const unsigned a_ = v[0], b_ = v[1]; v[0] = umax_(a_, b_); v[1] = umin_(a_, b_); }
  { const unsigned a_ = v[2], b_ = v[3]; v[2] = umax_(a_, b_); v[3] = umin_(a_, b_); }
  { const unsigned a_ = v[4], b_ = v[5]; v[4] = umax_(a_, b_); v[5] = umin_(a_, b_); }
  { const unsigned a_ = v[6], b_ = v[7]; v[6] = umax_(a_, b_); v[7] = umin_(a_, b_); }
  { const unsigned a_ = v[8], b_ = v[9]; v[8] = umax_(a_, b_); v[9] = umin_(a_, b_); }
  { const unsigned a_ = v[10], b_ = v[11]; v[10] = umax_(a_, b_); v[11] = umin_(a_, b_); }
  { const unsigned a_ = v[12], b_ = v[13]; v[12] = umax_(a_, b_); v[13] = umin_(a_, b_); }
  { const unsigned a_ = v[14], b_ = v[15]; v[14] = umax_(a_, b_); v[15] = umin_(a_, b_); }
}

DI void phase_route(const Params& P, int l) {
  const int tid_ = otid(); const int lane = tid_ & 63, w = tid_ >> 6;
  const u16* PQ = (const u16*)(P.ws + OFF_PQ);
  const u16* KEYS = (const u16*)(P.ws + OFF_KEYS);
  int* EIDX = (int*)(P.ws + OFF_EIDX);
  float* EG = (float*)(P.ws + OFF_EG);
  const int n = lane & 15, g4 = lane >> 4;
  for (int item = blockIdx.x * 4 + w; item < 1024 * 8; item += gridDim.x * 4) {
    const int hh = item & 7, t0 = (item >> 3) * 16;
    const u16* pq = PQ + (size_t)(t0 + n) * 1024 + hh * 128;
    unsigned v[2][32];
#pragma unroll
    for (int p = 0; p < 2; ++p) {
      const bf16x8 q0 = *(const bf16x8*)(pq + p * 64 + 8 * g4);
      const bf16x8 q1 = *(const bf16x8*)(pq + p * 64 + 32 + 8 * g4);
      const u16* kb = KEYS + (size_t)(((l * 8 + hh) * 2 + p) * 128) * 64;
#pragma unroll
      for (int mt = 0; mt < 8; ++mt) {
        const bf16x8 a0 = *(const bf16x8*)(kb + (size_t)(mt * 16 + n) * 64 + 8 * g4);
        const bf16x8 a1 = *(const bf16x8*)(kb + (size_t)(mt * 16 + n) * 64 + 32 + 8 * g4);
        f32x4 d = {0.f, 0.f, 0.f, 0.f};
        d = MFMA16(a0, q0, d);
        d = MFMA16(a1, q1, d);
#pragma unroll
        for (int i = 0; i < 4; ++i) v[p][mt * 4 + i] = sortkey(d[i], 0x7Fu, (unsigned)(127 - (mt * 16 + 4 * g4 + i)));
      }
    }
    float s1v[16], s2v[16];
    int i1[16], i2[16];
#pragma unroll
    for (int p = 0; p < 2; ++p) {
      sort32_top16(v[p]);
      merge16(v[p], 16);
      merge16(v[p], 32);
    }
#pragma unroll
    for (int it = 0; it < 16; ++it) {
      s1v[it] = unsortkey(v[0][it], 0x7Fu);
      i1[it] = 127 - (int)(v[0][it] & 0x7Fu);
      s2v[it] = unsortkey(v[1][it], 0x7Fu);
      i2[it] = 127 - (int)(v[1][it] & 0x7Fu);
    }
    float sa[4];
    int ia[4];
#pragma unroll
    for (int q = 0; q < 4; ++q) {
      sa[q] = sel4f(g4, s1v[4 * q], s1v[4 * q + 1], s1v[4 * q + 2], s1v[4 * q + 3]);
      ia[q] = sel4i(g4, i1[4 * q], i1[4 * q + 1], i1[4 * q + 2], i1[4 * q + 3]);
    }
    unsigned cand[21];
    int ce[21];
#pragma unroll
    for (int bb = 0; bb < 16; ++bb) {
      const bool ok = (g4 + 1) * (bb + 1) <= 16;
      cand[bb] = ok ? sortkey(sa[0] + s2v[bb], 0xFFu, (unsigned)(255 - (g4 * 16 + bb))) : 0u;
      ce[bb] = ia[0] * 128 + i2[bb];
    }
#pragma unroll
    for (int bb = 0; bb < 3; ++bb) {
      const bool ok = (5 + g4) * (bb + 1) <= 16;
      cand[16 + bb] = ok ? sortkey(sa[1] + s2v[bb], 0xFFu, (unsigned)(255 - ((4 + g4) * 16 + bb))) : 0u;
      ce[16 + bb] = ia[1] * 128 + i2[bb];
    }
    cand[19] = sortkey(sa[2] + s2v[0], 0xFFu, (unsigned)(255 - ((8 + g4) * 16)));
    ce[19] = ia[2] * 128 + i2[0];
    cand[20] = sortkey(sa[3] + s2v[0], 0xFFu, (unsigned)(255 - ((12 + g4) * 16)));
    ce[20] = ia[3] * 128 + i2[0];
    float sv[16];
    int* eo = EIDX + (size_t)(t0 + n) * 128 + hh * 16;
#pragma unroll
    for (int it = 0; it < 16; ++it) {
      unsigned mx = 0u;
#pragma unroll
      for (int j = 0; j < 21; ++j) mx = umax_(mx, cand[j]);
      mx = umax_(mx, shx(mx, 16));
      mx = umax_(mx, shx(mx, 32));
      sv[it] = unsortkey(mx, 0xFFu);
      int e = -1;
#pragma unroll
      for (int j = 0; j < 21; ++j) {
        const bool eq = (cand[j] == mx);
        e = eq ? ce[j] : e;
        cand[j] = eq ? 0u : cand[j];
      }
      if (e >= 0) eo[it] = e;
    }
    const float top = sv[0];
    float den = 0.f;
#pragma unroll
    for (int it = 0; it < 16; ++it) { sv[it] = __expf(sv[it] - top); den += sv[it]; }
    const float rden = 1.f / den;
    if (g4 == 0) {
      float* go = EG + (size_t)(t0 + n) * 128 + hh * 16;
#pragma unroll
      for (int q = 0; q < 4; ++q)
        *(float4*)(go + 4 * q) = make_float4(sv[4 * q] * rden, sv[4 * q + 1] * rden, sv[4 * q + 2] * rden, sv[4 * q + 3] * rden);
    }
  }
}

template <int B> DI f32x2 unp4(unsigned w) { return __builtin_amdgcn_cvt_scalef32_pk_f32_fp4(w, 1.0f, B); }
DI void cvt16(const u32x4& a, float (&f)[16]) {
#pragma unroll
  for (int q = 0; q < 4; ++q) {
    const f32x2 lo = __builtin_amdgcn_cvt_pk_f32_fp8(a[q], false);
    const f32x2 hi = __builtin_amdgcn_cvt_pk_f32_fp8(a[q], true);
    f[4 * q] = lo.x; f[4 * q + 1] = lo.y; f[4 * q + 2] = hi.x; f[4 * q + 3] = hi.y;
  }
}

DI void phase_gather(const Params& P, int l) {
  const int tid_ = otid(); const int lane = tid_ & 63, w = tid_ >> 6;
  const u16* H = (const u16*)(P.ws + OFF_H);
  const int* EIDX = (const int*)(P.ws + OFF_EIDX);
  const float* EG = (const float*)(P.ws + OFF_EG);
  const unsigned char* U = (const unsigned char*)(P.ws + OFF_U) + (size_t)l * 16384 * 512;
  const unsigned char* V = (const unsigned char*)(P.ws + OFF_V) + (size_t)l * 16384 * 512;
  const float* USC = (const float*)(P.ws + OFF_USC) + (size_t)l * 16384;
  const float* VSC = (const float*)(P.ws + OFF_VSC) + (size_t)l * 16384;
  const float* MODS = (const float*)(P.ws + OFF_MODS);
  float* X = (float*)(P.ws + OFF_X);
  u16* Hn = (u16*)(P.ws + OFF_H);
  for (int t = blockIdx.x * 4 + w; t < T; t += gridDim.x * 4) {
    float acc[16];
#pragma unroll
    for (int i = 0; i < 16; ++i) acc[i] = 0.f;
#if DO_PEER
    f32x2 hf2[8];
    {
      const u32x4 h0 = *(const u32x4*)(H + (size_t)t * 1024 + lane * 16);
      const u32x4 h1 = *(const u32x4*)(H + (size_t)t * 1024 + lane * 16 + 8);
#pragma unroll
      for (int q = 0; q < 4; ++q) {
        hf2[q] = (f32x2){bflo(h0[q]), bfhi(h0[q])};
        hf2[4 + q] = (f32x2){bflo(h1[q]), bfhi(h1[q])};
      }
    }
    const int e0 = EIDX[(size_t)t * 128 + lane], e1 = EIDX[(size_t)t * 128 + 64 + lane];
    const float g0 = EG[(size_t)t * 128 + lane] * VSC[e0], g1 = EG[(size_t)t * 128 + 64 + lane] * VSC[e1];
    const float su0 = USC[e0], su1 = USC[e1];
    float w0 = 0.f, w1 = 0.f;
    f32x2 acc2[8];
#pragma unroll 1
    for (int rep = 0; rep < REP_GATHER; ++rep) {
#pragma unroll
    for (int i = 0; i < 8; ++i) acc2[i] = (f32x2){0.f, 0.f};
    u32x2 bufA[32], bufB[32];
#define G_LOAD(BUF, TAB, C)                                                                   \
  _Pragma("unroll") for (int j = 0; j < 32; ++j) {                                            \
    const int idx_ = __builtin_amdgcn_readlane(((C) < 2) ? e0 : e1, (((C) & 1) << 5) + j);    \
    BUF[j] = *(const u32x2*)(TAB + (size_t)idx_ * 512 + lane * 8);                            \
  }
#define G_UCOMP(BUF, C)                                                                       \
  {                                                                                           \
    float p[32];                                                                              \
    _Pragma("unroll") for (int j = 0; j < 32; ++j) {                                          \
      f32x2 a2 = {0.f, 0.f};                                                                  \
      _Pragma("unroll") for (int d = 0; d < 2; ++d) {                                         \
        a2 = __builtin_elementwise_fma(unp4<0>(BUF[j][d]), hf2[4 * d + 0], a2);               \
        a2 = __builtin_elementwise_fma(unp4<1>(BUF[j][d]), hf2[4 * d + 1], a2);               \
        a2 = __builtin_elementwise_fma(unp4<2>(BUF[j][d]), hf2[4 * d + 2], a2);               \
        a2 = __builtin_elementwise_fma(unp4<3>(BUF[j][d]), hf2[4 * d + 3], a2);               \
      }                                                                                       \
      p[j] = a2.x + a2.y;                                                                     \
    }                                                                                         \
    float q1 = xsum32(p, lane);                                                               \
    q1 += __shfl_xor(q1, 32);                                                                 \
    const bool mine = (lane >> 5) == ((C) & 1);                                               \
    if ((C) < 2) w0 = mine ? gelu_tanh(q1 * su0) * g0 : w0;                                   \
    else w1 = mine ? gelu_tanh(q1 * su1) * g1 : w1;                                           \
  }
#define G_VCOMP(BUF, C)                                                                       \
  {                                                                                           \
    const float wv_ = ((C) < 2) ? w0 : w1;                                                    \
    _Pragma("unroll") for (int j = 0; j < 32; ++j) {                                          \
      const float wj = __int_as_float(__builtin_amdgcn_readlane(__float_as_int(wv_), (((C) & 1) << 5) + j)); \
      const f32x2 wv2 = {wj, wj};                                                             \
      _Pragma("unroll") for (int d = 0; d < 2; ++d) {                                         \
        acc2[4 * d + 0] = __builtin_elementwise_fma(wv2, unp4<0>(BUF[j][d]), acc2[4 * d + 0]); \
        acc2[4 * d + 1] = __builtin_elementwise_fma(wv2, unp4<1>(BUF[j][d]), acc2[4 * d + 1]); \
        acc2[4 * d + 2] = __builtin_elementwise_fma(wv2, unp4<2>(BUF[j][d]), acc2[4 * d + 2]); \
        acc2[4 * d + 3] = __builtin_elementwise_fma(wv2, unp4<3>(BUF[j][d]), acc2[4 * d + 3]); \
      }                                                                                       \
    }                                                                                         \
  }
#define G_SB __builtin_amdgcn_sched_barrier(0);
    G_LOAD(bufA, U, 0) G_SB
    G_LOAD(bufB, U, 1) G_SB  G_UCOMP(bufA, 0) G_SB
    G_LOAD(bufA, U, 2) G_SB  G_UCOMP(bufB, 1) G_SB
    G_LOAD(bufB, U, 3) G_SB  G_UCOMP(bufA, 2) G_SB
    G_LOAD(bufA, V, 0) G_SB  G_UCOMP(bufB, 3) G_SB
    G_LOAD(bufB, V, 1) G_SB  G_VCOMP(bufA, 0) G_SB
    G_LOAD(bufA, V, 2) G_SB  G_VCOMP(bufB, 1) G_SB
    G_LOAD(bufB, V, 3) G_SB  G_VCOMP(bufA, 2) G_SB
    G_VCOMP(bufB, 3)
#undef G_LOAD
#undef G_UCOMP
#undef G_VCOMP
#undef G_SB
    asm volatile("" : "+v"(w0), "+v"(w1));
    }
#pragma unroll
    for (int i = 0; i < 8; ++i) { acc[2 * i] = acc2[i].x; acc[2 * i + 1] = acc2[i].y; }
#endif
    const int b = t >> 12;
    const float* md = MODS + (size_t)(l * 4 + b) * 6144;
    float v[16];
#pragma unroll
    for (int half = 0; half < 2; ++half) {
      const int d0 = lane * 16 + half * 8;
      const float4 xa = *(const float4*)(X + (size_t)t * 1024 + d0), xb = *(const float4*)(X + (size_t)t * 1024 + d0 + 4);
      const float xv[8] = {xa.x, xa.y, xa.z, xa.w, xb.x, xb.y, xb.z, xb.w};
#pragma unroll
      for (int i = 0; i < 8; ++i) v[half * 8 + i] = DN_ALPHA * xv[i] + md[5120 + d0 + i] * acc[half * 8 + i];
    }
    const float* gam = P.ln_g + (size_t)(l * 2 + 1) * 1024;
    const float* bet = P.ln_b + (size_t)(l * 2 + 1) * 1024;
    if (l == NL - 1) {
      ln_finish<1>(v, (size_t)t, lane, gam, bet, nullptr, nullptr, P.out, nullptr);
    } else {
      const float* mdn = MODS + (size_t)((l + 1) * 4 + b) * 6144;
      ln_finish<1>(v, (size_t)t, lane, gam, bet, mdn, mdn + 1024, X, Hn);
    }
  }
}

#define XB_TMO      128
#define XB_XCNT(j)  (256  + 64 * (j))
#define XB_XSUB(j)  (1280 + 64 * (j))
#define XB_XGEN(j)  (2304 + 64 * (j))
#define XB_TOP      3328
#define XB_TOPGEN   3392
#define XCD_BAR_WORDS 3456
#define XB_SPIN_CAP (1u << 18)
#define LAS __attribute__((address_space(3)))

__device__ __forceinline__ unsigned xb_ld(unsigned* p)              { return __hip_atomic_load(p, __ATOMIC_RELAXED, __HIP_MEMORY_SCOPE_AGENT); }
__device__ __forceinline__ unsigned xb_add(unsigned* p, unsigned v) { return __hip_atomic_fetch_add(p, v, __ATOMIC_RELAXED, __HIP_MEMORY_SCOPE_AGENT); }
__device__ __forceinline__ unsigned xb_xcc_id() { return (unsigned)__builtin_amdgcn_s_getreg((3 << 11) | 20) & 0xFu; }
#define XB_SPIN(cond, bar) do { unsigned _sp = 0; while (cond) { __builtin_amdgcn_s_sleep(1); \
    if ((++_sp & 255u) == 0u) { if (xb_ld(&(bar)[XB_TMO])) break; if (_sp > XB_SPIN_CAP) { atomicAdd(&(bar)[XB_TMO], 1u); break; } } } } while (0)

struct XcdBarrier {
    unsigned* bar; unsigned x;
    volatile LAS unsigned* st;
};

__device__ __forceinline__ XcdBarrier xcd_barrier_post(unsigned* bar, volatile LAS unsigned* st) {
    XcdBarrier b; b.bar = bar; b.x = xb_xcc_id(); b.st = st;
    if (threadIdx.x == 0) (void)xb_add(&bar[XB_XCNT(b.x)], 1u);
    return b;
}
__device__ __forceinline__ void xcd_barrier_complete(unsigned* bar, unsigned x, unsigned& nloc, unsigned& nx) {
    const unsigned G = gridDim.x * gridDim.y * gridDim.z;
    unsigned sum, cnt, mine, sp = 0u;
    for (;;) {
        sum = 0u; cnt = 0u; mine = 0u;
#pragma unroll
        for (unsigned j = 0; j < 16; ++j) { const unsigned c = xb_ld(&bar[XB_XCNT(j)]); sum += c; cnt += (c > 0u) ? 1u : 0u; mine = (j == x) ? c : mine; }
        if (sum == G) break;
        __builtin_amdgcn_s_sleep(1);
        if ((++sp & 255u) == 0u) { if (xb_ld(&bar[XB_TMO])) break; if (sp > XB_SPIN_CAP) { atomicAdd(&bar[XB_TMO], 1u); break; } }
    }
    nloc = mine > 0u ? mine : 1u; nx = cnt > 0u ? cnt : 1u;
}

__device__ __forceinline__ void xcd_barrier(const XcdBarrier& b) {
    asm volatile("s_waitcnt vmcnt(0)" ::: "memory");
    __syncthreads();
    if (threadIdx.x == 0) {
        unsigned* bar = b.bar;
        __builtin_amdgcn_s_waitcnt(0);
        unsigned nloc = b.st[0], nx = b.st[1];
        if (nloc == 0u) { xcd_barrier_complete(bar, b.x, nloc, nx); b.st[0] = nloc; b.st[1] = nx; }
        const unsigned old = xb_add(&bar[XB_XSUB(b.x)], 1u);
        const unsigned gen = old / nloc;
        if (old + 1u == (gen + 1u) * nloc) {
            __builtin_amdgcn_fence(__ATOMIC_RELEASE, "agent");
            asm volatile("s_waitcnt vmcnt(0)" ::: "memory");
            const unsigned og = xb_add(&bar[XB_TOP], 1u);
            const unsigned tg = og / nx;
            if (og + 1u == (tg + 1u) * nx) xb_add(&bar[XB_TOPGEN], 1u);
            else XB_SPIN(xb_ld(&bar[XB_TOPGEN]) == tg, bar);
            __builtin_amdgcn_fence(__ATOMIC_ACQUIRE, "agent");
            xb_add(&bar[XB_XGEN(b.x)], 1u);
            asm volatile("s_waitcnt vmcnt(0)" ::: "memory");
        } else {
            XB_SPIN(xb_ld(&bar[XB_XGEN(b.x)]) == gen, bar);
            __builtin_amdgcn_fence(__ATOMIC_ACQUIRE, "agent");
            asm volatile("s_waitcnt vmcnt(0)" ::: "memory");
        }
    }
    __syncthreads();
}

__global__ void __launch_bounds__(256, 2) mega(Params P) {
  cg::grid_group grid = cg::this_grid();
  __shared__ __attribute__((aligned(16))) char smraw[73728];
  __shared__ uint4 xb_words;
  if (threadIdx.x == 0) xb_words = make_uint4(0u, 0u, 0u, 0u);
  __syncthreads();
  (void)xcd_barrier_post((unsigned*)(P.ws + OFF_BAR), (volatile LAS unsigned*)&xb_words);
#define XBAR() { XcdBarrier b_; b_.bar = (unsigned*)(P.ws + OFF_BAR); b_.x = xb_xcc_id(); b_.st = (volatile LAS unsigned*)&xb_words; xcd_barrier(b_); }
  phase0a(P, smraw);
  grid.sync();
  phase0b(P);
  XBAR()
  for (int l = 0; l < NL; ++l) {
#if DO_MIXER
#if PHM & 1
    for (int rep = 0; rep < REP_G1; ++rep) phase_gemm1(P, l, smraw);
#endif
    XBAR()
#if PHM & 2
    for (int rep = 0; rep < REP_CP; ++rep) phase_cmp_pool(P, l, smraw);
#endif
    XBAR()
#if PHM & 4
    for (int rep = 0; rep < REP_ATT; ++rep) phase_attn(P, l, smraw);
#endif
    XBAR()
#if PHM & 8
    phase_gemm2(P, l, smraw);
#endif
    XBAR()
#endif
    phase_gemm3(P, l, smraw);
    XBAR()
#if DO_PEER
#if PHM & 16
    phase_gemm4(P, l, smraw);
#endif
    XBAR()
#if PHM & 32
    for (int rep = 0; rep < REP_ROUTE; ++rep) phase_route(P, l);
#endif
    XBAR()
#endif
    phase_gather(P, l);
    XBAR()
  }
}

extern "C" void kernel_launch(void* const* d_in, const int* in_sizes, int n_in, void* d_out, int out_size, void* d_ws,
                              size_t ws_size, hipStream_t stream) {
  static int grid_blocks = 0;
  if (!grid_blocks) {
    int dev = 0, cus = 0, per_cu = 0;
    hipGetDevice(&dev);
    hipDeviceGetAttribute(&cus, hipDeviceAttributeMultiprocessorCount, dev);
    hipOccupancyMaxActiveBlocksPerMultiprocessor(&per_cu, mega, 256, 0);
    if (per_cu > 2) per_cu = 2;
    grid_blocks = cus * per_cu;
    if (per_cu < 2 || cus != 256) { fprintf(stderr, "unexpected occupancy %d x %d\n", cus, per_cu); grid_blocks = -1; }
  }
  if (grid_blocks <= 0) return;
  if (ws_size < WS_END) { fprintf(stderr, "workspace too small: %zu < %zu\n", ws_size, (size_t)WS_END); return; }
  Params p{};
  p.x = (const float*)d_in[0]; p.c = (const float*)d_in[1]; p.w_ada = (const float*)d_in[2]; p.b_ada = (const float*)d_in[3];
  p.w_in = (const float*)d_in[4]; p.cmp_pe = (const float*)d_in[5]; p.cmp_w1 = (const float*)d_in[6];
  p.cmp_w2 = (const float*)d_in[7]; p.w_pool = (const float*)d_in[8]; p.pool_scale = (const float*)d_in[9];
  p.w_lift = (const float*)d_in[10]; p.w_o = (const float*)d_in[11]; p.ln_g = (const float*)d_in[12];
  p.ln_b = (const float*)d_in[13]; p.peer_wq = (const float*)d_in[14]; p.peer_keys = (const float*)d_in[15];
  p.peer_u = (const float*)d_in[16]; p.peer_v = (const float*)d_in[17];
  p.out = (float*)d_out; p.ws = (char*)d_ws;
  hipMemsetAsync((char*)d_ws + OFF_BAR, 0, 16384, stream);
  void* args[] = {&p};
  hipError_t e = hipLaunchCooperativeKernel((void*)mega, dim3(grid_blocks), dim3(256), args, 0, stream);
  if (e != hipSuccess) fprintf(stderr, "cooperative launch failed: %s (grid %d)\n", hipGetErrorString(e), grid_blocks);
}
```
